# Optimizing an MI355X kernel written in HIP

```python
import jax, jax.numpy as jnp
from jax import lax
import numpy as np

D_MODEL = 2048
BATCH = 4
SEQ = 8192
DEPTH = 2
DEC_BATCH = 4
DEC_SEQ = 2048
PAST_LEN = 128

W_A = 512
A_GROUPS = 4
A_GDIM = W_A // A_GROUPS
W_B = 512
B_GROUPS = 4
B_GDIM = W_B // B_GROUPS
B_CHUNK = 128
C_CONFIGS = ((128, 1), (512, 4), (2048, 16))
C_NG = len(C_CONFIGS)
C_HEADS = 8
C_HEAD_DIM = 64
W_C = C_HEADS * C_HEAD_DIM
C_QKV = C_NG * W_C
ROPE_DIM = C_HEAD_DIM // 4
ROPE_THETA = 500000.0
N_BRANCH = 3
W_BR = 512
ALPHA = (2 * DEPTH) ** 0.25
BETA = (8 * DEPTH) ** -0.25
LN_EPS = 1e-5
NEG_BIG = -1e30

OFF_A = 0
OFF_AZ = OFF_A + W_A
OFF_B = OFF_AZ + W_A
OFF_BZ = OFF_B + 2 * W_B
OFF_C = OFF_BZ + W_B
OFF_CZ = OFF_C + 3 * C_QKV
OFF_G = OFF_CZ + W_C
N_IN = OFF_G + N_BRANCH * D_MODEL

kernel_name = 'hybrid_fnet_gmlp_dilated_encoder'


def _layer_norm(x, g, b):
    xf = x.astype(jnp.float32)
    mu = jnp.mean(xf, axis=-1, keepdims=True)
    var = jnp.mean(jnp.square(xf - mu), axis=-1, keepdims=True)
    y = (xf - mu) * lax.rsqrt(var + LN_EPS) * g.astype(jnp.float32) + b.astype(jnp.float32)
    return y.astype(x.dtype)


def _rotary(t, pos):
    half = ROPE_DIM // 2
    inv_freq = ROPE_THETA ** (-jnp.arange(half, dtype=jnp.float32) / half)
    ang = pos[:, None] * inv_freq[None, :]
    cos = jnp.cos(ang)[None, :, None, :]
    sin = jnp.sin(ang)[None, :, None, :]
    tr = t[..., :ROPE_DIM].astype(jnp.float32)
    t1, t2 = tr[..., :half], tr[..., half:]
    rot = jnp.concatenate([t1 * cos - t2 * sin, t2 * cos + t1 * sin], axis=-1).astype(t.dtype)
    return jnp.concatenate([rot, t[..., ROPE_DIM:]], axis=-1)


def _fourier_mixer(a, w_map):
    B, S, _ = a.shape
    ag = a.reshape(B, S, A_GROUPS, A_GDIM).astype(jnp.float32)
    f = jnp.fft.fft2(ag, axes=(1, 3), norm='ortho').real.astype(a.dtype)
    out = jnp.einsum('bsgc,gcd->bsgd', f, w_map)
    return out.reshape(B, S, W_A)


def _spatial_gating(uv, ln_g, ln_b, w_s, b_s):
    B, S, _ = uv.shape
    uv = jax.nn.gelu(uv)
    u, v = uv[..., :W_B], uv[..., W_B:]
    v = _layer_norm(v, ln_g, ln_b)
    vc = v.reshape(B, S // B_CHUNK, B_CHUNK, B_GROUPS, B_GDIM)
    mixed = jnp.einsum('gpq,bnqgc->bnpgc', w_s, vc) + b_s.T[None, None, :, :, None]
    return u * mixed.reshape(B, S, W_B)


def _dilated_window_attention(q, k, v, dil, half):
    B, S, H, D = q.shape
    L = S // dil
    N = B * dil

    def split(t):
        return t.reshape(B, L, dil, H, D).transpose(0, 2, 1, 3, 4).reshape(N, L, H, D)

    qs, ks, vs = split(q), split(k), split(v)
    blk = half
    nb = -(-L // blk)
    Lp = nb * blk
    qb = jnp.pad(qs, ((0, 0), (0, Lp - L), (0, 0), (0, 0))).reshape(N, nb, blk, H, D)
    pad_kv = ((0, 0), (blk, Lp - L + blk), (0, 0), (0, 0))
    kb = jnp.pad(ks, pad_kv).reshape(N, nb + 2, blk, H, D)
    vb = jnp.pad(vs, pad_kv).reshape(N, nb + 2, blk, H, D)
    kw = jnp.concatenate([kb[:, :-2], kb[:, 1:-1], kb[:, 2:]], axis=2)
    vw = jnp.concatenate([vb[:, :-2], vb[:, 1:-1], vb[:, 2:]], axis=2)
    scale = 1.0 / np.sqrt(D).astype(np.float32)
    scores = jnp.einsum('nbqhd,nbkhd->nbhqk', qb, kw,
                        preferred_element_type=jnp.float32) * scale
    qpos = jnp.arange(nb)[:, None] * blk + jnp.arange(blk)[None, :]
    kpos = jnp.arange(nb)[:, None] * blk - blk + jnp.arange(3 * blk)[None, :]
    valid = ((jnp.abs(qpos[:, :, None] - kpos[:, None, :]) <= half)
             & (kpos[:, None, :] >= 0) & (kpos[:, None, :] < L))
    scores = jnp.where(valid[None, :, None], scores, NEG_BIG)
    lse = jax.nn.logsumexp(scores, axis=-1)
    p = jnp.exp(scores - lse[..., None])
    out = jnp.einsum('nbhqk,nbkhd->nbqhd', p, vw.astype(jnp.float32))
    out = out.reshape(N, Lp, H, D)[:, :L]
    lse = lse.transpose(0, 1, 3, 2).reshape(N, Lp, H)[:, :L]
    out = out.reshape(B, dil, L, H, D).transpose(0, 2, 1, 3, 4).reshape(B, S, H, D)
    lse = lse.reshape(B, dil, L, H).transpose(0, 2, 1, 3).reshape(B, S, H)
    return out, lse


def _dilated_mixer(qkv):
    B, S, _ = qkv.shape
    pos = jnp.arange(S, dtype=jnp.float32)
    q = _rotary(qkv[..., :C_QKV].reshape(B, S, C_NG * C_HEADS, C_HEAD_DIM), pos)
    k = _rotary(qkv[..., C_QKV:2 * C_QKV].reshape(B, S, C_NG * C_HEADS, C_HEAD_DIM), pos)
    v = qkv[..., 2 * C_QKV:].reshape(B, S, C_NG * C_HEADS, C_HEAD_DIM)
    outs, lses = [], []
    for g, (window, dil) in enumerate(C_CONFIGS):
        hs = slice(g * C_HEADS, (g + 1) * C_HEADS)
        o, l = _dilated_window_attention(q[:, :, hs], k[:, :, hs], v[:, :, hs], dil, window // (2 * dil))
        outs.append(o)
        lses.append(l)
    w = jax.nn.softmax(jnp.stack(lses, axis=0), axis=0)
    out = jnp.sum(w[..., None] * jnp.stack(outs, axis=0), axis=0)
    return out.reshape(B, S, W_C).astype(qkv.dtype)


def _encoder_layer(x, w_in, w_amap, sgu_ln_g, sgu_ln_b, sgu_w, sgu_b, w_branch, w_out, ln_g, ln_b):
    B, S, _ = x.shape
    h = x @ w_in
    y_a = _fourier_mixer(h[..., OFF_A:OFF_AZ], w_amap) * jax.nn.silu(h[..., OFF_AZ:OFF_B])
    y_b = _spatial_gating(h[..., OFF_B:OFF_BZ], sgu_ln_g, sgu_ln_b, sgu_w, sgu_b) * jax.nn.silu(h[..., OFF_BZ:OFF_C])
    y_c = _dilated_mixer(h[..., OFF_C:OFF_CZ]) * jax.nn.silu(h[..., OFF_CZ:OFF_G])
    ys = jnp.stack([y_a, y_b, y_c], axis=2)
    proj = jnp.einsum('bskc,kcd->bskd', ys, w_branch)
    gates = jax.nn.sigmoid(h[..., OFF_G:].reshape(B, S, N_BRANCH, D_MODEL))
    merged = jnp.sum(gates * proj, axis=2)
    out = merged @ w_out
    return _layer_norm(ALPHA * x + out, ln_g, ln_b)


def _trunk(x, w_in, w_amap, sgu_ln_g, sgu_ln_b, sgu_w, sgu_b, w_branch, w_out, ln_g, ln_b):
    for l in range(DEPTH):
        x = _encoder_layer(x, w_in[l], w_amap[l], sgu_ln_g[l], sgu_ln_b[l], sgu_w[l], sgu_b[l],
                           w_branch[l], w_out[l], ln_g[l], ln_b[l])
    return x


def setup_inputs(seed: int = 0) -> dict:
    key = jax.random.key(seed)
    ks = jax.random.split(key, 12)
    f32 = jnp.float32
    x_prompt = jax.random.normal(ks[0], (BATCH, SEQ, D_MODEL), f32)
    x_sample = jax.random.normal(ks[1], (DEC_BATCH, DEC_SEQ, D_MODEL), f32)
    w_in = jax.random.normal(ks[2], (DEPTH, D_MODEL, N_IN), f32) * D_MODEL ** -0.5
    w_amap = jax.random.normal(ks[3], (DEPTH, A_GROUPS, A_GDIM, A_GDIM), f32) * A_GDIM ** -0.5
    sgu_ln_g = 1.0 + 0.02 * jax.random.normal(ks[4], (DEPTH, W_B), f32)
    sgu_ln_b = 0.02 * jax.random.normal(ks[5], (DEPTH, W_B), f32)
    sgu_w = jax.random.normal(ks[6], (DEPTH, B_GROUPS, B_CHUNK, B_CHUNK), f32) * B_CHUNK ** -0.5
    sgu_b = 0.02 * jax.random.normal(ks[7], (DEPTH, B_GROUPS, B_CHUNK), f32)
    w_branch = jax.random.normal(ks[8], (DEPTH, N_BRANCH, W_BR, D_MODEL), f32) * (W_BR ** -0.5 * BETA)
    w_out = jax.random.normal(ks[9], (DEPTH, D_MODEL, D_MODEL), f32) * (D_MODEL ** -0.5 * BETA)
    ln_g = 1.0 + 0.02 * jax.random.normal(ks[10], (DEPTH, D_MODEL), f32)
    ln_b = 0.02 * jax.random.normal(ks[11], (DEPTH, D_MODEL), f32)
    return {'x_prompt': x_prompt, 'x_sample': x_sample, 'w_in': w_in, 'w_amap': w_amap,
            'sgu_ln_g': sgu_ln_g, 'sgu_ln_b': sgu_ln_b, 'sgu_w': sgu_w, 'sgu_b': sgu_b,
            'w_branch': w_branch, 'w_out': w_out, 'ln_g': ln_g, 'ln_b': ln_b}


def reference(x_prompt, x_sample, w_in, w_amap, sgu_ln_g, sgu_ln_b, sgu_w, sgu_b, w_branch, w_out, ln_g, ln_b):
    y_prompt = _trunk(x_prompt, w_in, w_amap, sgu_ln_g, sgu_ln_b, sgu_w, sgu_b, w_branch, w_out, ln_g, ln_b)
    y_sample = _trunk(x_sample, w_in, w_amap, sgu_ln_g, sgu_ln_b, sgu_w, sgu_b, w_branch, w_out, ln_g, ln_b)
    return (y_prompt, y_sample)
```

```cpp
#include <hip/hip_runtime.h>
#include <hip/hip_cooperative_groups.h>
#include <cstdio>
namespace cg = cooperative_groups;

#ifndef SINGLE_LAUNCH
#define SINGLE_LAUNCH 0
#endif

#define LAS __attribute__((address_space(3)))
typedef unsigned short bf16_t;
typedef short bf16x8 __attribute__((ext_vector_type(8)));
typedef short bf16x4 __attribute__((ext_vector_type(4)));
typedef float f32x4 __attribute__((ext_vector_type(4)));
typedef float f32x2 __attribute__((ext_vector_type(2)));
typedef unsigned u32x4 __attribute__((ext_vector_type(4)));
typedef unsigned u32x2 __attribute__((ext_vector_type(2)));

constexpr int T = 40960, TP = 32768, DM = 2048;
constexpr int SP = 8192, SS = 2048;
constexpr int NW = 14336;
constexpr int NIN = 13824;
constexpr int NTHREADS = 512;
constexpr float ALPHA = 1.41421356237309515f;
constexpr float LN_EPS = 1e-5f;

constexpr size_t al256(size_t x) { return (x + 255) & ~(size_t)255; }
constexpr size_t WS_CTL = 0;
constexpr size_t WS_ROPE = WS_CTL + 4096;
constexpr size_t WS_XB = WS_ROPE + al256((size_t)8192 * 8 * 8);
constexpr size_t WS_WIN = WS_XB + (size_t)T * 2048 * 2;
constexpr size_t WS_WB = WS_WIN + (size_t)NW * 2048 * 2;
constexpr size_t WS_WOUT = WS_WB + (size_t)2 * 3 * 2048 * 2048 * 2;
constexpr size_t WS_DP = WS_WOUT + (size_t)2 * 2048 * 2048 * 2;
constexpr size_t WS_DS = WS_DP + (size_t)8192 * 16384 * 2;
constexpr size_t WS_PQTP = WS_DS + (size_t)2048 * 4096 * 2;
constexpr size_t WS_PQTS = WS_PQTP + (size_t)4 * 512 * 16384 * 2;
constexpr size_t WS_YS = WS_PQTS + (size_t)4 * 512 * 4096 * 2;
constexpr size_t WS_VB = WS_YS + (size_t)T * 2048 * 2;
constexpr size_t WS_BZ = WS_VB + (size_t)T * 512 * 2;
constexpr size_t WS_QKV = WS_BZ + (size_t)T * 512 * 2;
constexpr size_t WS_MERGED = WS_QKV;
constexpr size_t WS_SCR = WS_MERGED + (size_t)T * 2048 * 2;
constexpr size_t SCR_PER_WG = 384 * 1024;
constexpr size_t WS_LSE = WS_QKV + (size_t)T * 4608 * 2;
constexpr size_t WS_END = WS_LSE + (size_t)T * 24 * 4;
static_assert(WS_SCR + 256 * SCR_PER_WG <= WS_LSE, "scratch alias");
constexpr int YLD = 2048;

constexpr int LDS_BYTES = 128 * 1024 + 256;

__device__ __forceinline__ unsigned cvt_pk_bf16(float lo, float hi) { unsigned r; asm volatile("v_cvt_pk_bf16_f32 %0, %1, %2" : "=v"(r) : "v"(lo), "v"(hi)); return r; }
__device__ __forceinline__ float bf_lo(unsigned w) { return __uint_as_float(w << 16); }
__device__ __forceinline__ float bf_hi(unsigned w) { return __uint_as_float(w & 0xffff0000u); }
__device__ __forceinline__ float bf1(bf16_t b) { return __uint_as_float(((unsigned)b) << 16); }
__device__ __forceinline__ float sigmoid_f(float x) { return 1.0f / (1.0f + __expf(-x)); }
__device__ __forceinline__ float silu_f(float x) { return x * sigmoid_f(x); }
__device__ __forceinline__ float gelu_f(float x) { const float y = 1.5957691216057308f * (x + 0.044715f * x * x * x); return x * sigmoid_f(y); }

__device__ __forceinline__ int tid_opaque() { int t = threadIdx.x; asm volatile("" : "+v"(t)); return t; }

struct Args {
    const float* in[12];
    float* out;
    unsigned char* ws;
    int ph_lo, ph_hi;
};

namespace pg8 {
constexpr int BM = 256, BK = 64, HALF = 128, HTB = HALF * BK * 2, STAGE_BYTES = 8 * HTB;
__device__ __forceinline__ int lds_byte(int r, int c) { const int st = (r >> 4) * 2 + (c >> 5), rr = r & 15, cc = c & 31, ob = rr * 64 + cc * 2; return st * 1024 + (ob ^ (((ob >> 9) & 1) << 5)); }
__device__ __forceinline__ void stage_rc(int b, int& R, int& C) { const int st = b / 1024, sb = b % 1024, swz = sb ^ (((sb >> 9) & 1) << 5); R = (st >> 1) * 16 + swz / 64; C = (st & 1) * 32 + (swz % 64) / 2; }
__device__ __forceinline__ int perm32(int rho) { const int n = rho >> 4, i = rho & 15; return 8 * (i >> 2) + 4 * n + (i & 3); }

struct Unit { const char* A; const char* B; int nt, pm, pn, aux; };

__device__ __forceinline__ bool grid_tile(int L, int nM, int nN, int& pm, int& pn) {
    const int nwg = nM * nN; if (L >= nwg) return false;
    int wgid = L; { const int q = nwg / 8, r = nwg % 8, xcd = wgid % 8, off = wgid / 8; wgid = (xcd < r ? xcd * (q + 1) : r * (q + 1) + (xcd - r) * q) + off; }
    const int nig = 8 * nN, gid = wgid / nig, fm = gid * 8, gsz = (nM - fm) < 8 ? (nM - fm) : 8;
    pm = fm + ((wgid % nig) % gsz); pn = (wgid % nig) / gsz; return true;
}

template <class Epi, class Sched>
__device__ __forceinline__ void gemm_phase(LAS unsigned char* lds, const int lda, const int ldb, const Sched& S, const Epi& E) {
    const int tid = tid_opaque(), wid = __builtin_amdgcn_readfirstlane(tid >> 6), lane = tid & 63, wr = wid >> 2, wc = wid & 3, fr = lane & 15, fq = lane >> 4;
    unsigned voffA[2], voffB[2];
#pragma unroll
    for (int i = 0; i < 2; ++i) { int R, C; stage_rc(tid * 16 + i * 8192, R, C); const int Rb = Epi::PERM ? ((R & ~31) + perm32(R & 31)) : R;
        voffA[i] = (unsigned)(R * lda + C) * 2u; voffB[i] = (unsigned)(Rb * ldb + C) * 2u; }
    const size_t kstep = (size_t)(BK * 2);
    const size_t hstepA = (size_t)HALF * lda * 2, hstepB = (size_t)HALF * ldb * 2;
    const unsigned ldsw = (unsigned)wid * 1024u;
    const int aoff = lds_byte(wr * 64 + fr, fq * 8), boff = lds_byte(wc * 32 + fr, fq * 8);
#define PG8_SA(b, h) (((b) * 2 + (h)) * HTB)
#define PG8_SB(b, h) ((4 + (b) * 2 + (h)) * HTB)
#define PG8_STAGE(bufoff, gbase, voff) do { _Pragma("unroll") for (int _i = 0; _i < 2; ++_i) \
        __builtin_amdgcn_global_load_lds((const unsigned*)((const char*)(gbase) + (voff)[_i]), (LAS unsigned*)(lds + (bufoff) + ldsw + _i * 8192), 16, 0, 0); } while (0)
#define PG8_LDA(dst, b, h) do { _Pragma("unroll") for (int m = 0; m < 4; ++m) _Pragma("unroll") for (int k = 0; k < 2; ++k) dst[m][k] = *(const LAS bf16x8*)(lds + PG8_SA(b, h) + aoff + m * 2048 + k * 1024); } while (0)
#define PG8_LDB(dst, b, h) do { _Pragma("unroll") for (int n = 0; n < 2; ++n) _Pragma("unroll") for (int k = 0; k < 2; ++k) dst[n][k] = *(const LAS bf16x8*)(lds + PG8_SB(b, h) + boff + n * 2048 + k * 1024); } while (0)
#define PG8_MMA(ai, bj, At, Bt) do { __builtin_amdgcn_s_setprio(1); _Pragma("unroll") for (int m = 0; m < 4; ++m) _Pragma("unroll") for (int n = 0; n < 2; ++n) _Pragma("unroll") for (int k = 0; k < 2; ++k) \
        acc[ai][bj][m][n] = __builtin_amdgcn_mfma_f32_16x16x32_bf16(Bt[n][k], At[m][k], acc[ai][bj][m][n], 0, 0, 0); __builtin_amdgcn_s_setprio(0); } while (0)
#define PG8_WAIT_V(n) asm volatile("s_waitcnt vmcnt(" #n ")" ::: "memory")
#define PG8_WAIT_L(n) asm volatile("s_waitcnt lgkmcnt(" #n ")" ::: "memory")
#define PG8_BAR __builtin_amdgcn_s_barrier()
#define PG8_SCHED __builtin_amdgcn_sched_barrier(0)
    Unit cur, nxt; int ui = 0;
    if (!S.next(0, cur)) return;
    f32x4 acc[2][2][4][2];
#pragma unroll
    for (int a = 0; a < 2; ++a)
#pragma unroll
        for (int b = 0; b < 2; ++b)
#pragma unroll
            for (int m = 0; m < 4; ++m)
#pragma unroll
                for (int n = 0; n < 2; ++n) acc[a][b][m][n] = (f32x4){0.f, 0.f, 0.f, 0.f};
    bf16x8 At[4][2], B0[2][2], B1[2][2];
    const char* cA = cur.A; const char* cB = cur.B;
    PG8_STAGE(PG8_SB(0, 0), cB, voffB); PG8_STAGE(PG8_SB(0, 1), cB + hstepB, voffB); PG8_STAGE(PG8_SA(0, 0), cA, voffA); PG8_STAGE(PG8_SA(0, 1), cA + hstepA, voffA);
    if (wr == 1) PG8_BAR;
    PG8_WAIT_V(2); PG8_BAR;
    PG8_STAGE(PG8_SB(1, 0), cB + kstep, voffB); PG8_STAGE(PG8_SA(1, 0), cA + kstep, voffA); PG8_STAGE(PG8_SB(1, 1), cB + hstepB + kstep, voffB);
    PG8_WAIT_V(6); PG8_BAR;
    for (;;) {
        const bool has_next = S.next(ui + 1, nxt);
        const char* nA = has_next ? nxt.A : cA; const char* nB = has_next ? nxt.B : cB;
        const int nt = cur.nt;
        for (int t = 0; t < nt; t += 2) {
            const bool last = (t == nt - 2);
            const char* a1 = cA + (size_t)(t + 1) * kstep;
            const char* a2 = last ? nA : cA + (size_t)(t + 2) * kstep; const char* b2 = last ? nB : cB + (size_t)(t + 2) * kstep;
            const char* a3 = a2 + kstep; const char* b3 = b2 + kstep;
            PG8_LDB(B0, 0, 0); PG8_LDB(B1, 0, 1); PG8_SCHED; PG8_LDA(At, 0, 0); PG8_STAGE(PG8_SA(1, 1), a1 + hstepA, voffA);
            PG8_WAIT_V(8); PG8_WAIT_L(0); PG8_BAR; PG8_MMA(0, 0, At, B0); PG8_MMA(0, 1, At, B1); PG8_BAR; PG8_SCHED;
            PG8_LDA(At, 0, 1); PG8_STAGE(PG8_SB(0, 0), b2, voffB); PG8_STAGE(PG8_SB(0, 1), b2 + hstepB, voffB); PG8_STAGE(PG8_SA(0, 0), a2, voffA);
            PG8_WAIT_V(8); PG8_WAIT_L(0); PG8_BAR; PG8_MMA(1, 0, At, B0); PG8_MMA(1, 1, At, B1); PG8_BAR; PG8_SCHED;
            PG8_LDB(B0, 1, 0); PG8_LDB(B1, 1, 1); PG8_SCHED; PG8_LDA(At, 1, 0); PG8_STAGE(PG8_SA(0, 1), a2 + hstepA, voffA);
            PG8_WAIT_V(8); PG8_WAIT_L(0); PG8_BAR; PG8_MMA(0, 0, At, B0); PG8_MMA(0, 1, At, B1); PG8_BAR; PG8_SCHED;
            PG8_LDA(At, 1, 1); PG8_STAGE(PG8_SB(1, 0), b3, voffB); PG8_STAGE(PG8_SB(1, 1), b3 + hstepB, voffB); PG8_STAGE(PG8_SA(1, 0), a3, voffA);
            PG8_WAIT_V(8); PG8_WAIT_L(0); PG8_BAR; PG8_MMA(1, 0, At, B0); PG8_MMA(1, 1, At, B1); PG8_BAR; PG8_SCHED;
        }
        if (wr == 0) PG8_BAR;
        E(acc, cur, wr, wc, fr, fq);
        if (!has_next) break;
#pragma unroll
        for (int a = 0; a < 2; ++a)
#pragma unroll
            for (int b = 0; b < 2; ++b)
#pragma unroll
                for (int m = 0; m < 4; ++m)
#pragma unroll
                    for (int n = 0; n < 2; ++n) acc[a][b][m][n] = (f32x4){0.f, 0.f, 0.f, 0.f};
        cur = nxt; cA = nA; cB = nB; ++ui;
        if (wr == 1) PG8_BAR;
    }
    PG8_WAIT_V(0);
    PG8_BAR;
#undef PG8_SA
#undef PG8_SB
#undef PG8_STAGE
#undef PG8_LDA
#undef PG8_LDB
#undef PG8_MMA
#undef PG8_WAIT_V
#undef PG8_WAIT_L
#undef PG8_BAR
#undef PG8_SCHED
}
}
using pg8::Unit;

struct SchedIn {
    const char* A; const char* B; int G, c;
    __device__ __forceinline__ bool next(int i, Unit& u) const {
        int pm, pn; if (!pg8::grid_tile(i * G + c, T / 256, 32, pm, pn)) return false;
        u.A = A + (size_t)pm * 256 * 2048 * 2; u.B = B + (size_t)pn * 256 * 2048 * 2; u.nt = 32; u.pm = pm; u.pn = pn; u.aux = 0; return true;
    }
};
struct SchedDftP {
    const char* A; const char* B; int G, c;
    __device__ __forceinline__ bool next(int i, Unit& u) const {
        const int L = i * G + c; if (L >= 256) return false;
        const int x = L & 7, o = L >> 3; u.pm = 4 * x + (o & 3); u.pn = o >> 2; u.aux = 0; u.nt = 256;
        u.A = A + (size_t)u.pm * 256 * 16384 * 2; u.B = B + (size_t)u.pn * 256 * 16384 * 2; return true;
    }
};
struct SchedDftS {
    const char* A; const char* B; int G, c;
    __device__ __forceinline__ bool next(int i, Unit& u) const {
        const int L = i * G + c; if (L >= 64) return false;
        u.pm = L & 7; u.pn = L >> 3; u.aux = 1; u.nt = 64;
        u.A = A + (size_t)u.pm * 256 * 4096 * 2; u.B = B + (size_t)u.pn * 256 * 4096 * 2; return true;
    }
};
struct SchedP3 {
    const char* X; const char* WG; const char* Y; const char* WBp; int G, c;
    __device__ __forceinline__ bool next(int i, Unit& u) const {
        const int ti = i / 6, sub = i - 6 * ti, k = sub >> 1; int pm, pn; if (!pg8::grid_tile(ti * G + c, T / 256, 8, pm, pn)) return false;
        u.pm = pm; u.pn = pn; u.aux = sub;
        if ((sub & 1) == 0) { u.A = X + (size_t)pm * 256 * 2048 * 2; u.B = WG + ((size_t)k * 2048 + (size_t)pn * 256) * 2048 * 2; u.nt = 32; }
        else { u.A = Y + ((size_t)pm * 256 * 2048 + (size_t)k * 512) * 2; u.B = WBp + ((size_t)k * 2048 + (size_t)pn * 256) * 2048 * 2; u.nt = 8; }
        return true;
    }
};
struct SchedOut {
    const char* A; const char* B; int G, c;
    __device__ __forceinline__ bool next(int i, Unit& u) const {
        int pm, pn; if (!pg8::grid_tile(i * G + c, T / 256, 8, pm, pn)) return false;
        u.A = A + (size_t)pm * 256 * 2048 * 2; u.B = B + (size_t)pn * 256 * 2048 * 2; u.nt = 32; u.pm = pm; u.pn = pn; u.aux = 0; return true;
    }
};

struct EpiIn {
    static constexpr bool PERM = true;
    bf16_t *ys, *vb, *bz, *qkv, *pqtp, *pqts; const f32x2* rope;
    __device__ __forceinline__ void operator()(const f32x4 (&acc)[2][2][4][2], const Unit& u, int wr, int wc, int fr, int fq) const {
        const int pn = u.pn;
        const int row0 = u.pm * 256 + wr * 64 + fr;
        const int cl0 = wc * 32 + 8 * fq;
        if (pn < 4) {
            const int part = pn >> 1; const int j0 = (pn & 1) * 256 + cl0;
            bf16_t* base; size_t ldj; int srow0;
            const int trow = u.pm * 256;
            if (trow < TP) { const int seq = trow >> 13; ldj = 16384; base = pqtp + (size_t)seq * 512 * 16384 + (size_t)part * 8192; srow0 = row0 - (seq << 13); }
            else { const int t2 = trow - TP; const int seq = t2 >> 11; ldj = 4096; base = pqts + (size_t)seq * 512 * 4096 + (size_t)part * 2048; srow0 = row0 - TP - (seq << 11); }
#pragma unroll
            for (int ai = 0; ai < 2; ++ai)
#pragma unroll
                for (int m = 0; m < 4; ++m) {
                    const int s = srow0 + ai * 128 + m * 16;
#pragma unroll
                    for (int bj = 0; bj < 2; ++bj) {
                        const f32x4 v0 = acc[ai][bj][m][0], v1 = acc[ai][bj][m][1];
                        bf16_t* p = base + (size_t)(j0 + bj * 128) * ldj + s;
                        const unsigned w0 = cvt_pk_bf16(v0[0], v0[1]), w1 = cvt_pk_bf16(v0[2], v0[3]), w2 = cvt_pk_bf16(v1[0], v1[1]), w3 = cvt_pk_bf16(v1[2], v1[3]);
                        p[0] = (bf16_t)(w0 & 0xffff); p[ldj] = (bf16_t)(w0 >> 16); p[2 * ldj] = (bf16_t)(w1 & 0xffff); p[3 * ldj] = (bf16_t)(w1 >> 16);
                        p[4 * ldj] = (bf16_t)(w2 & 0xffff); p[5 * ldj] = (bf16_t)(w2 >> 16); p[6 * ldj] = (bf16_t)(w3 & 0xffff); p[7 * ldj] = (bf16_t)(w3 >> 16);
                    }
                }
            return;
        }
        int kind; bf16_t* base; int ld; int coff;
        if (pn < 6) { kind = 1; base = ys; ld = YLD; coff = (pn - 4) * 256; }
        else if (pn < 8) { kind = 2; base = ys; ld = YLD; coff = 512 + (pn - 6) * 256; }
        else if (pn < 10) { kind = 2; base = vb; ld = 512; coff = (pn - 8) * 256; }
        else if (pn < 12) { kind = 1; base = bz; ld = 512; coff = (pn - 10) * 256; }
        else if (pn < 30) { kind = (pn < 24) ? 4 : 0; base = qkv; ld = 4608; coff = (pn - 12) * 256; }
        else { kind = 1; base = ys; ld = YLD; coff = 1024 + (pn - 30) * 256; }
        const bool do_rope = (kind == 4) && ((wc & 1) == 0);
#pragma unroll
        for (int ai = 0; ai < 2; ++ai)
#pragma unroll
            for (int m = 0; m < 4; ++m) {
                const int row = row0 + ai * 128 + m * 16;
                bf16_t* rowp = base + (size_t)row * ld + coff + cl0;
                f32x2 cs[8];
                if (do_rope) {
                    const int pos = (row < TP) ? (row & 8191) : ((row - TP) & 2047);
                    const f32x4* rp = (const f32x4*)(rope + (size_t)pos * 8);
#pragma unroll
                    for (int i = 0; i < 4; ++i) { const f32x4 t4 = rp[i]; cs[2 * i] = (f32x2){t4[0], t4[1]}; cs[2 * i + 1] = (f32x2){t4[2], t4[3]}; }
                }
#pragma unroll
                for (int bj = 0; bj < 2; ++bj) {
                    float v[8];
#pragma unroll
                    for (int i = 0; i < 4; ++i) { v[i] = acc[ai][bj][m][0][i]; v[4 + i] = acc[ai][bj][m][1][i]; }
                    if (kind == 1) {
#pragma unroll
                        for (int i = 0; i < 8; ++i) v[i] = silu_f(v[i]);
                    } else if (kind == 2) {
#pragma unroll
                        for (int i = 0; i < 8; ++i) v[i] = gelu_f(v[i]);
                    } else if (do_rope) {
#pragma unroll
                        for (int i = 0; i < 8; ++i) {
                            const float o = __shfl_xor(v[i], 16);
                            const float r1 = v[i] * cs[i][0] - o * cs[i][1];
                            const float r2 = v[i] * cs[i][0] + o * cs[i][1];
                            v[i] = (fq == 0) ? r1 : ((fq == 1) ? r2 : v[i]);
                        }
                    }
                    u32x4 w; w.x = cvt_pk_bf16(v[0], v[1]); w.y = cvt_pk_bf16(v[2], v[3]); w.z = cvt_pk_bf16(v[4], v[5]); w.w = cvt_pk_bf16(v[6], v[7]);
                    *(u32x4*)(rowp + bj * 128) = w;
                }
            }
    }
};

struct EpiDft {
    static constexpr bool PERM = true;
    bf16_t* ys;
    __device__ __forceinline__ void operator()(const f32x4 (&acc)[2][2][4][2], const Unit& u, int wr, int wc, int fr, int fq) const {
        const int S = u.aux ? SS : SP; const int tb = u.aux ? TP : 0;
        const float scale = u.aux ? 0.001953125f : 0.0009765625f;
        const int seq = u.pn >> 1; const int j0 = (u.pn & 1) * 256 + wc * 32 + 8 * fq;
        const int k0 = u.pm * 256 + wr * 64 + fr;
#pragma unroll
        for (int ai = 0; ai < 2; ++ai)
#pragma unroll
            for (int m = 0; m < 4; ++m) {
                const int tok = tb + seq * S + k0 + ai * 128 + m * 16;
                bf16_t* rowp = ys + (size_t)tok * YLD + j0;
#pragma unroll
                for (int bj = 0; bj < 2; ++bj) {
                    const u32x4 z = *(const u32x4*)(rowp + bj * 128);
                    const f32x4 v0 = acc[ai][bj][m][0] * scale, v1 = acc[ai][bj][m][1] * scale;
                    u32x4 w;
                    w.x = cvt_pk_bf16(v0[0] * bf_lo(z.x), v0[1] * bf_hi(z.x)); w.y = cvt_pk_bf16(v0[2] * bf_lo(z.y), v0[3] * bf_hi(z.y));
                    w.z = cvt_pk_bf16(v1[0] * bf_lo(z.z), v1[1] * bf_hi(z.z)); w.w = cvt_pk_bf16(v1[2] * bf_lo(z.w), v1[3] * bf_hi(z.w));
                    *(u32x4*)(rowp + bj * 128) = w;
                }
                asm volatile("" ::: "memory");
            }
    }
};

struct EpiP3 {
    static constexpr bool PERM = true;
    u32x4* sg; f32x4* sm; bf16_t* merged;
    __device__ __forceinline__ void operator()(const f32x4 (&acc)[2][2][4][2], const Unit& u, int wr, int wc, int fr, int fq) const {
        const int sub = u.aux, k = sub >> 1;
        const int tid = (wr * 4 + wc) * 64 + fq * 16 + fr;
        if ((sub & 1) == 0) {
#pragma unroll
            for (int ai = 0; ai < 2; ++ai)
#pragma unroll
                for (int m = 0; m < 4; ++m)
#pragma unroll
                    for (int bj = 0; bj < 2; ++bj) {
                        const f32x4 v0 = acc[ai][bj][m][0], v1 = acc[ai][bj][m][1];
                        u32x4 w; w.x = cvt_pk_bf16(sigmoid_f(v0[0]), sigmoid_f(v0[1])); w.y = cvt_pk_bf16(sigmoid_f(v0[2]), sigmoid_f(v0[3]));
                        w.z = cvt_pk_bf16(sigmoid_f(v1[0]), sigmoid_f(v1[1])); w.w = cvt_pk_bf16(sigmoid_f(v1[2]), sigmoid_f(v1[3]));
                        { unsigned o = (unsigned)tid * 16u; asm volatile("" : "+v"(o)); *(u32x4*)((char*)sg + (size_t)(((ai * 4 + m) * 2 + bj) * 8192) + o) = w; }
                        asm volatile("" ::: "memory");
                    }
            return;
        }
        const int row0 = u.pm * 256 + wr * 64 + fr; const int c0 = u.pn * 256 + wc * 32 + 8 * fq;
#pragma unroll
        for (int ai = 0; ai < 2; ++ai)
#pragma unroll
            for (int m = 0; m < 4; ++m) {
#pragma unroll
                for (int bj = 0; bj < 2; ++bj) {
                    const int idx = (ai * 4 + m) * 2 + bj;
                    unsigned o = (unsigned)tid * 16u; asm volatile("" : "+v"(o));
                    const u32x4 z = *(const u32x4*)((const char*)sg + (size_t)(idx * 8192) + o);
                    f32x4 v0 = acc[ai][bj][m][0], v1 = acc[ai][bj][m][1];
                    v0[0] *= bf_lo(z.x); v0[1] *= bf_hi(z.x); v0[2] *= bf_lo(z.y); v0[3] *= bf_hi(z.y);
                    v1[0] *= bf_lo(z.z); v1[1] *= bf_hi(z.z); v1[2] *= bf_lo(z.w); v1[3] *= bf_hi(z.w);
                    f32x4* mp = (f32x4*)((char*)sm + (size_t)(idx * 16384) + o);
                    if (k > 0) { v0 += mp[0]; v1 += mp[512]; }
                    if (k < 2) { mp[0] = v0; mp[512] = v1; }
                    else { u32x4 w; w.x = cvt_pk_bf16(v0[0], v0[1]); w.y = cvt_pk_bf16(v0[2], v0[3]); w.z = cvt_pk_bf16(v1[0], v1[1]); w.w = cvt_pk_bf16(v1[2], v1[3]);
                        *(u32x4*)(merged + (size_t)(row0 + ai * 128 + m * 16) * 2048 + c0 + bj * 128) = w; }
                }
                asm volatile("" ::: "memory");
            }
    }
};

struct EpiOut {
    static constexpr bool PERM = false;
    const float* xp; const float* xs; float* out;
    __device__ __forceinline__ void operator()(const f32x4 (&acc)[2][2][4][2], const Unit& u, int wr, int wc, int fr, int fq) const {
        const int row0 = u.pm * 256 + wr * 64 + fr; const int c0 = u.pn * 256 + wc * 32 + 4 * fq;
#pragma unroll
        for (int ai = 0; ai < 2; ++ai)
#pragma unroll
            for (int m = 0; m < 4; ++m) {
                const int row = row0 + ai * 128 + m * 16;
                const float* xr = (row < TP) ? (xp + (size_t)row * 2048) : (xs + (size_t)(row - TP) * 2048);
                float* orow = out + (size_t)row * 2048;
#pragma unroll
                for (int bj = 0; bj < 2; ++bj)
#pragma unroll
                    for (int n = 0; n < 2; ++n) {
                        const int c = c0 + bj * 128 + n * 16;
                        const f32x4 xv = *(const f32x4*)(xr + c);
                        *(f32x4*)(orow + c) = xv * ALPHA + acc[ai][bj][m][n];
                    }
                asm volatile("" ::: "memory");
            }
    }
};

__device__ __forceinline__ void transpose_tile(LAS float* buf, const float* src, int ld_src, bf16_t* dst, int ld_dst, int r0, int c0) {
    const int tid = tid_opaque();
#pragma unroll
    for (int i = 0; i < 2; ++i) { const int e = tid + 512 * i; const int r = e >> 4, c4 = (e & 15) * 4;
        const f32x4 v = *(const f32x4*)(src + (size_t)(r0 + r) * ld_src + c0 + c4);
        buf[r * 65 + c4] = v[0]; buf[r * 65 + c4 + 1] = v[1]; buf[r * 65 + c4 + 2] = v[2]; buf[r * 65 + c4 + 3] = v[3]; }
    __syncthreads();
    { const int c = tid >> 3, r8 = (tid & 7) * 8; float v[8];
#pragma unroll
      for (int j = 0; j < 8; ++j) v[j] = buf[(r8 + j) * 65 + c];
      u32x4 w; w.x = cvt_pk_bf16(v[0], v[1]); w.y = cvt_pk_bf16(v[2], v[3]); w.z = cvt_pk_bf16(v[4], v[5]); w.w = cvt_pk_bf16(v[6], v[7]);
      *(u32x4*)(dst + (size_t)(c0 + c) * ld_dst + r0 + r8) = w; }
    __syncthreads();
}

__device__ __forceinline__ void prep_win_transpose(LAS unsigned char* lds, const float* w_in_l, bf16_t* win) {
    LAS float* buf = (LAS float*)lds;
    const int ntr = 2048 / 64, ntc = (NIN - 512) / 64;
    for (int it = blockIdx.x; it < ntr * ntc; it += gridDim.x) {
        const int tr = it % ntr, tc = it / ntr;
        transpose_tile(buf, w_in_l, NIN, win + (size_t)512 * 2048, 2048, tr * 64, 512 + tc * 64);
    }
}
__device__ __forceinline__ void prep_win_fold(LAS unsigned char* lds, const float* w_in_l, const float* w_amap_l, bf16_t* win) {
    LAS float* tt = (LAS float*)lds;
    LAS float* Mx = (LAS float*)(lds + 1024);
    const int tid = tid_opaque();
    for (int it = blockIdx.x; it < 256; it += gridDim.x) {
        const int pg = it >> 5, dr = it & 31; const int part = pg >> 2, g = pg & 3;
        if (tid < 128) tt[tid] = part == 0 ? cospif((float)tid * (1.0f / 64.0f)) : sinpif((float)tid * (1.0f / 64.0f));
        __syncthreads();
        {
            const int dd = tid & 127, cg4 = tid >> 7;
            float a[32];
#pragma unroll
            for (int i = 0; i < 32; ++i) a[i] = 0.f;
            const float* wm = w_amap_l + (size_t)g * 128 * 128 + dd;
            for (int cp = 0; cp < 128; ++cp) {
                const float w = wm[(size_t)cp * 128];
#pragma unroll
                for (int i = 0; i < 32; ++i) a[i] += tt[((cg4 * 32 + i) * cp) & 127] * w;
            }
#pragma unroll
            for (int i = 0; i < 32; ++i) Mx[(cg4 * 32 + i) * 128 + dd] = a[i];
        }
        __syncthreads();
        {
            const int dd = tid & 127, dg = tid >> 7;
            const int d0 = dr * 64 + dg * 16;
            float a[16];
#pragma unroll
            for (int i = 0; i < 16; ++i) a[i] = 0.f;
            const float* wa = w_in_l + (size_t)d0 * NIN + g * 128;
            for (int c = 0; c < 128; ++c) {
                const float mv = Mx[c * 128 + dd];
#pragma unroll
                for (int i = 0; i < 16; ++i) a[i] += wa[(size_t)i * NIN + c] * mv;
            }
            bf16_t* dp = win + (size_t)(part * 512 + g * 128 + dd) * 2048 + d0;
            u32x4 w0, w1;
            w0.x = cvt_pk_bf16(a[0], a[1]); w0.y = cvt_pk_bf16(a[2], a[3]); w0.z = cvt_pk_bf16(a[4], a[5]); w0.w = cvt_pk_bf16(a[6], a[7]);
            w1.x = cvt_pk_bf16(a[8], a[9]); w1.y = cvt_pk_bf16(a[10], a[11]); w1.z = cvt_pk_bf16(a[12], a[13]); w1.w = cvt_pk_bf16(a[14], a[15]);
            *(u32x4*)dp = w0; *(u32x4*)(dp + 8) = w1;
        }
        __syncthreads();
    }
}

__device__ __forceinline__ void prep_phase(LAS unsigned char* lds, const Args& a) {
    unsigned char* ws = a.ws;
    const int tid = tid_opaque();
    const float* xp = a.in[0]; const float* xs = a.in[1];
    {
        bf16_t* xb = (bf16_t*)(ws + WS_XB);
        const size_t nch = (size_t)T * 256;
        for (size_t cid = (size_t)blockIdx.x * NTHREADS + tid; cid < nch; cid += (size_t)gridDim.x * NTHREADS) {
            const int tok = (int)(cid >> 8), c8 = (int)(cid & 255) * 8;
            const float* src = (tok < TP) ? (xp + (size_t)tok * 2048 + c8) : (xs + (size_t)(tok - TP) * 2048 + c8);
            const f32x4 v0 = *(const f32x4*)src, v1 = *(const f32x4*)(src + 4);
            u32x4 w; w.x = cvt_pk_bf16(v0[0], v0[1]); w.y = cvt_pk_bf16(v0[2], v0[3]); w.z = cvt_pk_bf16(v1[0], v1[1]); w.w = cvt_pk_bf16(v1[2], v1[3]);
            *(u32x4*)(xb + (size_t)tok * 2048 + c8) = w;
        }
    }
    {
        f32x2* rope = (f32x2*)(ws + WS_ROPE);
        for (int idx = blockIdx.x * NTHREADS + tid; idx < 8192 * 8; idx += gridDim.x * NTHREADS) {
            const int pos = idx >> 3, i = idx & 7;
            const float inv = powf(500000.0f, -(float)i * 0.125f);
            const float ang = (float)pos * inv;
            rope[idx] = (f32x2){cosf(ang), sinf(ang)};
        }
    }
    {
        LAS float* ct = (LAS float*)lds;
        for (int m = tid; m < 8192; m += NTHREADS) ct[m] = cospif((float)m * (1.0f / 4096.0f));
        __syncthreads();
        bf16_t* dp = (bf16_t*)(ws + WS_DP); bf16_t* ds = (bf16_t*)(ws + WS_DS);
        for (int k = blockIdx.x; k < 8192; k += gridDim.x) {
            for (int ch = tid; ch < 2048; ch += NTHREADS) {
                const int col = ch * 8; const int sn = col >= 8192; const int s0 = col & 8191;
                float v[8];
#pragma unroll
                for (int j = 0; j < 8; ++j) { const int mm = (k * (s0 + j)) & 8191; v[j] = sn ? -ct[(mm - 2048) & 8191] : ct[mm]; }
                u32x4 w; w.x = cvt_pk_bf16(v[0], v[1]); w.y = cvt_pk_bf16(v[2], v[3]); w.z = cvt_pk_bf16(v[4], v[5]); w.w = cvt_pk_bf16(v[6], v[7]);
                *(u32x4*)(dp + (size_t)k * 16384 + col) = w;
            }
        }
        for (int k = blockIdx.x; k < 2048; k += gridDim.x) {
            { const int ch = tid; const int col = ch * 8; const int sn = col >= 2048; const int s0 = col & 2047;
                float v[8];
#pragma unroll
                for (int j = 0; j < 8; ++j) { const int mm = (4 * k * (s0 + j)) & 8191; v[j] = sn ? -ct[(mm - 2048) & 8191] : ct[mm]; }
                u32x4 w; w.x = cvt_pk_bf16(v[0], v[1]); w.y = cvt_pk_bf16(v[2], v[3]); w.z = cvt_pk_bf16(v[4], v[5]); w.w = cvt_pk_bf16(v[6], v[7]);
                *(u32x4*)(ds + (size_t)k * 4096 + col) = w; }
        }
        __syncthreads();
    }
    {
        LAS float* buf = (LAS float*)lds;
        const float* wbr = a.in[8]; const float* wo = a.in[9];
        bf16_t* wb = (bf16_t*)(ws + WS_WB); bf16_t* wout = (bf16_t*)(ws + WS_WOUT);
        for (int it = blockIdx.x; it < 6 * 8 * 32; it += gridDim.x) {
            const int lk = it / 256, r = it % 256; const int tr = r & 7, tc = r >> 3;
            transpose_tile(buf, wbr + (size_t)lk * 512 * 2048, 2048, wb + (size_t)lk * 2048 * 2048, 2048, tr * 64, tc * 64);
        }
        for (int it = blockIdx.x; it < 2 * 32 * 32; it += gridDim.x) {
            const int l = it / 1024, r = it % 1024; const int tr = r & 31, tc = r >> 5;
            transpose_tile(buf, wo + (size_t)l * 2048 * 2048, 2048, wout + (size_t)l * 2048 * 2048, 2048, tr * 64, tc * 64);
        }
    }
    prep_win_transpose(lds, a.in[2], (bf16_t*)(ws + WS_WIN));
    prep_win_fold(lds, a.in[2], a.in[3], (bf16_t*)(ws + WS_WIN));
}

__device__ __forceinline__ void sgu_item(LAS unsigned char* lds, bf16_t* ys, const bf16_t* vb, const bf16_t* bz, const float* sw, const float* sb, const float* lg, const float* lb, int item) {
    const int tid = tid_opaque(), lane = tid & 63, wid = tid >> 6;
    const int cidx = item >> 2, g = item & 3; const int t0 = cidx * 128;
    LAS bf16_t* vT = (LAS bf16_t*)lds;
    {
        const int q = tid >> 2, part = tid & 3;
        const bf16_t* vrow = vb + (size_t)(t0 + q) * 512;
        float s = 0.f, ss = 0.f;
#pragma unroll
        for (int i = 0; i < 16; ++i) {
            const u32x4 z = *(const u32x4*)(vrow + part * 128 + i * 8);
            const float f0 = bf_lo(z.x), f1 = bf_hi(z.x), f2 = bf_lo(z.y), f3 = bf_hi(z.y), f4 = bf_lo(z.z), f5 = bf_hi(z.z), f6 = bf_lo(z.w), f7 = bf_hi(z.w);
            s += ((f0 + f1) + (f2 + f3)) + ((f4 + f5) + (f6 + f7));
            ss += ((f0 * f0 + f1 * f1) + (f2 * f2 + f3 * f3)) + ((f4 * f4 + f5 * f5) + (f6 * f6 + f7 * f7));
        }
        s += __shfl_xor(s, 1); s += __shfl_xor(s, 2); ss += __shfl_xor(ss, 1); ss += __shfl_xor(ss, 2);
        const float mean = s * (1.0f / 512.0f); const float var = fmaxf(ss * (1.0f / 512.0f) - mean * mean, 0.f); const float rstd = rsqrtf(var + LN_EPS);
#pragma unroll
        for (int i = 0; i < 4; ++i) {
            const int c = part * 32 + i * 8;
            const u32x4 z = *(const u32x4*)(vrow + g * 128 + c);
            float f[8] = {bf_lo(z.x), bf_hi(z.x), bf_lo(z.y), bf_hi(z.y), bf_lo(z.z), bf_hi(z.z), bf_lo(z.w), bf_hi(z.w)};
#pragma unroll
            for (int e = 0; e < 8; e += 2) {
                const float y0 = (f[e] - mean) * rstd * lg[g * 128 + c + e] + lb[g * 128 + c + e];
                const float y1 = (f[e + 1] - mean) * rstd * lg[g * 128 + c + e + 1] + lb[g * 128 + c + e + 1];
                const unsigned w = cvt_pk_bf16(y0, y1);
                vT[(c + e) * 136 + q] = (bf16_t)(w & 0xffff); vT[(c + e + 1) * 136 + q] = (bf16_t)(w >> 16);
            }
        }
    }
    __syncthreads();
    {
        const int fr = lane & 15, quad = lane >> 4; const int p = wid * 16 + fr;
        bf16x8 bw[4];
        const float* wrow = sw + ((size_t)g * 128 + p) * 128;
#pragma unroll
        for (int ks = 0; ks < 4; ++ks) {
            const f32x4 a0 = *(const f32x4*)(wrow + ks * 32 + quad * 8), a1 = *(const f32x4*)(wrow + ks * 32 + quad * 8 + 4);
            u32x4 w; w.x = cvt_pk_bf16(a0[0], a0[1]); w.y = cvt_pk_bf16(a0[2], a0[3]); w.z = cvt_pk_bf16(a1[0], a1[1]); w.w = cvt_pk_bf16(a1[2], a1[3]);
            bw[ks] = __builtin_bit_cast(bf16x8, w);
        }
        const float bias = sb[g * 128 + p];
        const int t = t0 + p;
#pragma unroll
        for (int mt = 0; mt < 8; ++mt) {
            f32x4 acc = (f32x4){0.f, 0.f, 0.f, 0.f};
#pragma unroll
            for (int ks = 0; ks < 4; ++ks) {
                const bf16x8 av = *(const LAS bf16x8*)(vT + (16 * mt + fr) * 136 + ks * 32 + quad * 8);
                acc = __builtin_amdgcn_mfma_f32_16x16x32_bf16(av, bw[ks], acc, 0, 0, 0);
            }
            const int c4 = g * 128 + 16 * mt + 4 * quad;
            bf16_t* up = ys + (size_t)t * YLD + 512 + c4;
            const u32x2 uz = *(const u32x2*)up; const u32x2 zz = *(const u32x2*)(bz + (size_t)t * 512 + c4);
            u32x2 w;
            w.x = cvt_pk_bf16(bf_lo(uz.x) * (acc[0] + bias) * bf_lo(zz.x), bf_hi(uz.x) * (acc[1] + bias) * bf_hi(zz.x));
            w.y = cvt_pk_bf16(bf_lo(uz.y) * (acc[2] + bias) * bf_lo(zz.y), bf_hi(uz.y) * (acc[3] + bias) * bf_hi(zz.y));
            *(u32x2*)up = w;
        }
    }
    __syncthreads();
}

__device__ __forceinline__ void attn_item(LAS unsigned char* lds, bf16_t* qkv, float* lse, int item) {
    const int tid = tid_opaque(), lane = tid & 63, wid = tid >> 6;
    const int gh = item % 24, ua = item / 24; const int g = gh >> 3;
    int tbase, S, u;
    if (ua < 256) { const int sq = ua >> 6; u = ua & 63; S = SP; tbase = sq * SP; }
    else { const int v = ua - 256; const int sq = v >> 4; u = v & 15; S = SS; tbase = TP + sq * SS; }
    const int dsh = 2 * g; const int dil = 1 << dsh; const int L = S >> dsh;
    const int r = u & (dil - 1), sp = u >> dsh; const int m0 = sp * 128;
    const int qcol = gh * 64, kcol = 1536 + gh * 64, vcol = 3072 + gh * 64;
    constexpr int KST = 72, VST = 280;
    LAS bf16_t* Ks = (LAS bf16_t*)lds;
    LAS bf16_t* Vt = (LAS bf16_t*)(lds + 272 * KST * 2);
#pragma unroll
    for (int i = 0; i < 4; ++i) {
        const int e = tid + 512 * i; const int key = e >> 3, dch = e & 7;
        const int mk = m0 - 64 + key; const bool ok = (mk >= 0) && (mk < L);
        u32x4 kz = (u32x4){0u, 0u, 0u, 0u}, vz = (u32x4){0u, 0u, 0u, 0u};
        if (ok) { const bf16_t* rowp = qkv + (size_t)(tbase + mk * dil + r) * 4608; kz = *(const u32x4*)(rowp + kcol + dch * 8); vz = *(const u32x4*)(rowp + vcol + dch * 8); }
        *(LAS u32x4*)(Ks + key * KST + dch * 8) = kz;
        LAS bf16_t* vp = Vt + (dch * 8) * VST + key;
        vp[0] = (bf16_t)(vz.x & 0xffff); vp[VST] = (bf16_t)(vz.x >> 16); vp[2 * VST] = (bf16_t)(vz.y & 0xffff); vp[3 * VST] = (bf16_t)(vz.y >> 16);
        vp[4 * VST] = (bf16_t)(vz.z & 0xffff); vp[5 * VST] = (bf16_t)(vz.z >> 16); vp[6 * VST] = (bf16_t)(vz.w & 0xffff); vp[7 * VST] = (bf16_t)(vz.w >> 16);
    }
    if (tid < 128) { const int key = 256 + (tid >> 3), dch = tid & 7;
        *(LAS u32x4*)(Ks + key * KST + dch * 8) = (u32x4){0u, 0u, 0u, 0u};
        LAS bf16_t* vp = Vt + (dch * 8) * VST + key;
#pragma unroll
        for (int j = 0; j < 8; ++j) vp[j * VST] = 0; }
    __syncthreads();
    {
        const int fr = lane & 15, quad = lane >> 4;
        const int ql = 16 * wid + fr; const int mq = m0 + ql;
        bf16_t* qrow = qkv + (size_t)(tbase + mq * dil + r) * 4608 + qcol;
        bf16x8 bq[2];
        bq[0] = *(const bf16x8*)(qrow + quad * 8); bq[1] = *(const bf16x8*)(qrow + 32 + quad * 8);
        float sc[10][4];
        float mx = -3.0e38f;
#pragma unroll
        for (int ti = 0; ti < 10; ++ti) {
            const int kk0 = 16 * (wid + ti);
            f32x4 acc = (f32x4){0.f, 0.f, 0.f, 0.f};
#pragma unroll
            for (int ks = 0; ks < 2; ++ks) {
                const bf16x8 ka = *(const LAS bf16x8*)(Ks + (kk0 + fr) * KST + ks * 32 + quad * 8);
                acc = __builtin_amdgcn_mfma_f32_16x16x32_bf16(ka, bq[ks], acc, 0, 0, 0);
            }
#pragma unroll
            for (int j = 0; j < 4; ++j) {
                const int kk = kk0 + 4 * quad + j; const int dlt = kk - ql; const int mk = m0 - 64 + kk;
                const bool ok = (dlt >= 0) && (dlt <= 128) && (mk >= 0) && (mk < L);
                const float sv = ok ? acc[j] * 0.125f : -1.0e30f;
                sc[ti][j] = sv; mx = fmaxf(mx, sv);
            }
        }
        mx = fmaxf(mx, __shfl_xor(mx, 16)); mx = fmaxf(mx, __shfl_xor(mx, 32));
        float sum = 0.f;
#pragma unroll
        for (int ti = 0; ti < 10; ++ti)
#pragma unroll
            for (int j = 0; j < 4; ++j) { const float p = exp2f((sc[ti][j] - mx) * 1.4426950408889634f); sc[ti][j] = p; sum += p; }
        sum += __shfl_xor(sum, 16); sum += __shfl_xor(sum, 32);
        bf16x8 pb[5];
#pragma unroll
        for (int k2 = 0; k2 < 5; ++k2) {
            u32x4 w; w.x = cvt_pk_bf16(sc[2 * k2][0], sc[2 * k2][1]); w.y = cvt_pk_bf16(sc[2 * k2][2], sc[2 * k2][3]);
            w.z = cvt_pk_bf16(sc[2 * k2 + 1][0], sc[2 * k2 + 1][1]); w.w = cvt_pk_bf16(sc[2 * k2 + 1][2], sc[2 * k2 + 1][3]);
            pb[k2] = __builtin_bit_cast(bf16x8, w);
        }
        const float inv = 1.0f / sum;
#pragma unroll
        for (int mt = 0; mt < 4; ++mt) {
            f32x4 o = (f32x4){0.f, 0.f, 0.f, 0.f};
#pragma unroll
            for (int k2 = 0; k2 < 5; ++k2) {
                const LAS bf16_t* vp = Vt + (16 * mt + fr) * VST + 16 * (wid + 2 * k2) + 4 * quad;
                const u32x2 lo = *(const LAS u32x2*)vp, hi = *(const LAS u32x2*)(vp + 16);
                const u32x4 w = (u32x4){lo.x, lo.y, hi.x, hi.y};
                o = __builtin_amdgcn_mfma_f32_16x16x32_bf16(__builtin_bit_cast(bf16x8, w), pb[k2], o, 0, 0, 0);
            }
            u32x2 w; w.x = cvt_pk_bf16(o[0] * inv, o[1] * inv); w.y = cvt_pk_bf16(o[2] * inv, o[3] * inv);
            *(u32x2*)(qrow + 16 * mt + 4 * quad) = w;
        }
        if (quad == 0) lse[(size_t)(tbase + mq * dil + r) * 24 + gh] = mx + __logf(sum);
    }
    __syncthreads();
}

__device__ __forceinline__ void combine_phase(bf16_t* ys, const bf16_t* qkv, const float* lse) {
    const size_t n = (size_t)T * 64;
    const int tid = tid_opaque();
    for (size_t id = (size_t)blockIdx.x * NTHREADS + tid; id < n; id += (size_t)gridDim.x * NTHREADS) {
        const int t = (int)(id >> 6), h = (int)(id >> 3) & 7, ch = (int)id & 7;
        const float l0 = lse[(size_t)t * 24 + h], l1 = lse[(size_t)t * 24 + 8 + h], l2 = lse[(size_t)t * 24 + 16 + h];
        const float mx = fmaxf(l0, fmaxf(l1, l2));
        float w0 = __expf(l0 - mx), w1 = __expf(l1 - mx), w2 = __expf(l2 - mx);
        const float inv = 1.0f / (w0 + w1 + w2); w0 *= inv; w1 *= inv; w2 *= inv;
        const bf16_t* qr = qkv + (size_t)t * 4608 + h * 64 + ch * 8;
        const u32x4 o0 = *(const u32x4*)qr, o1 = *(const u32x4*)(qr + 512), o2 = *(const u32x4*)(qr + 1024);
        bf16_t* yp = ys + (size_t)t * YLD + 1024 + h * 64 + ch * 8;
        const u32x4 z = *(const u32x4*)yp;
        u32x4 w;
        w.x = cvt_pk_bf16((w0 * bf_lo(o0.x) + w1 * bf_lo(o1.x) + w2 * bf_lo(o2.x)) * bf_lo(z.x), (w0 * bf_hi(o0.x) + w1 * bf_hi(o1.x) + w2 * bf_hi(o2.x)) * bf_hi(z.x));
        w.y = cvt_pk_bf16((w0 * bf_lo(o0.y) + w1 * bf_lo(o1.y) + w2 * bf_lo(o2.y)) * bf_lo(z.y), (w0 * bf_hi(o0.y) + w1 * bf_hi(o1.y) + w2 * bf_hi(o2.y)) * bf_hi(z.y));
        w.z = cvt_pk_bf16((w0 * bf_lo(o0.z) + w1 * bf_lo(o1.z) + w2 * bf_lo(o2.z)) * bf_lo(z.z), (w0 * bf_hi(o0.z) + w1 * bf_hi(o1.z) + w2 * bf_hi(o2.z)) * bf_hi(z.z));
        w.w = cvt_pk_bf16((w0 * bf_lo(o0.w) + w1 * bf_lo(o1.w) + w2 * bf_lo(o2.w)) * bf_lo(z.w), (w0 * bf_hi(o0.w) + w1 * bf_hi(o1.w) + w2 * bf_hi(o2.w)) * bf_hi(z.w));
        *(u32x4*)yp = w;
    }
}

__device__ __forceinline__ void ln_phase(float* out, bf16_t* xb, const float* lg, const float* lb, bool write_bf) {
    const int tid = tid_opaque(); const int lane = tid & 63, wid = tid >> 6;
    for (int row = blockIdx.x * 8 + wid; row < T; row += gridDim.x * 8) {
        float* rp = out + (size_t)row * 2048;
        f32x4 v[8]; float s = 0.f;
#pragma unroll
        for (int i = 0; i < 8; ++i) { v[i] = *(const f32x4*)(rp + i * 256 + lane * 4); s += (v[i][0] + v[i][1]) + (v[i][2] + v[i][3]); }
#pragma unroll
        for (int o = 32; o >= 1; o >>= 1) s += __shfl_xor(s, o);
        const float mean = s * (1.0f / 2048.0f); float q = 0.f;
#pragma unroll
        for (int i = 0; i < 8; ++i) { const f32x4 d = v[i] - mean; q += (d[0] * d[0] + d[1] * d[1]) + (d[2] * d[2] + d[3] * d[3]); }
#pragma unroll
        for (int o = 32; o >= 1; o >>= 1) q += __shfl_xor(q, o);
        const float rstd = rsqrtf(q * (1.0f / 2048.0f) + LN_EPS);
#pragma unroll
        for (int i = 0; i < 8; ++i) {
            const int c = i * 256 + lane * 4;
            const f32x4 gg = *(const f32x4*)(lg + c), bb = *(const f32x4*)(lb + c);
            const f32x4 y = (v[i] - mean) * rstd * gg + bb;
            *(f32x4*)(rp + c) = y;
            if (write_bf) { u32x2 w; w.x = cvt_pk_bf16(y[0], y[1]); w.y = cvt_pk_bf16(y[2], y[3]); *(u32x2*)(xb + (size_t)row * 2048 + c) = w; }
        }
    }
}

__global__ void __launch_bounds__(NTHREADS) fwd_kernel(Args a) {
    extern __shared__ __attribute__((aligned(16))) unsigned char lds_raw[];
    LAS unsigned char* lds = (LAS unsigned char*)lds_raw;
    unsigned char* ws = a.ws;
    const int G = gridDim.x, c = blockIdx.x;
    const int lo = a.ph_lo, hi = a.ph_hi;
#ifndef P2SUB
#define P2SUB 0xf
#endif
#ifndef PMASK
#define PMASK 0xff
#endif
#define IN(k) (lo <= (k) && (k) < hi)
#define SEAM(k) do { if (IN(k) && IN((k) + 1)) { cg::this_grid().sync(); } } while (0)
    bf16_t* xb = (bf16_t*)(ws + WS_XB); bf16_t* win = (bf16_t*)(ws + WS_WIN);
    bf16_t* ys = (bf16_t*)(ws + WS_YS); bf16_t* vb = (bf16_t*)(ws + WS_VB); bf16_t* bzb = (bf16_t*)(ws + WS_BZ);
    bf16_t* qkv = (bf16_t*)(ws + WS_QKV); float* lse = (float*)(ws + WS_LSE);
    bf16_t* merged = (bf16_t*)(ws + WS_MERGED);
    unsigned* ctl = (unsigned*)(ws + WS_CTL);
    LAS int* qslot = (LAS int*)(lds + 128 * 1024);

    if (IN(0) && (PMASK & 1)) { prep_phase(lds, a); }
    SEAM(0);
#pragma nounroll
    for (int l = 0; l < 2; ++l) {
        const int pb = 1 + 6 * l;
        if (IN(pb) && (PMASK & 2)) {
            SchedIn S{(const char*)xb, (const char*)win, G, c};
            EpiIn E{ys, vb, bzb, qkv, (bf16_t*)(ws + WS_PQTP), (bf16_t*)(ws + WS_PQTS), (const f32x2*)(ws + WS_ROPE)};
            pg8::gemm_phase<EpiIn, SchedIn>(lds, 2048, 2048, S, E);
        }
        SEAM(pb);
        if (IN(pb + 1) && (PMASK & 4)) {
            EpiDft E{ys};
            if (P2SUB & 1) { SchedDftP S{(const char*)(ws + WS_DP), (const char*)(ws + WS_PQTP), G, c}; pg8::gemm_phase<EpiDft, SchedDftP>(lds, 16384, 16384, S, E); }
            if (P2SUB & 2) { SchedDftS S{(const char*)(ws + WS_DS), (const char*)(ws + WS_PQTS), G, c}; pg8::gemm_phase<EpiDft, SchedDftS>(lds, 4096, 4096, S, E); }
            const float* sw = a.in[6] + (size_t)l * 4 * 128 * 128; const float* sb = a.in[7] + (size_t)l * 4 * 128;
            const float* slg = a.in[4] + (size_t)l * 512; const float* slb = a.in[5] + (size_t)l * 512;
            constexpr int N_SGU = (T / 128) * 4, N_ATT = (T / 128) * 24;
            for (;;) {
                __syncthreads();
                if (tid_opaque() == 0) qslot[0] = (int)atomicAdd(ctl + 16 * (l + 1), 1u);
                __syncthreads();
                const int item = qslot[0];
                if (item >= N_SGU + N_ATT) break;
                if (item < N_SGU) { if (P2SUB & 4) sgu_item(lds, ys, vb, bzb, sw, sb, slg, slb, item); }
                else { if (P2SUB & 8) attn_item(lds, qkv, lse, item - N_SGU); }
            }
        }
        SEAM(pb + 1);
        if (IN(pb + 2) && (PMASK & 8)) {
            combine_phase(ys, qkv, lse);
        }
        SEAM(pb + 2);
        if (IN(pb + 3) && (PMASK & 16)) {
            SchedP3 S{(const char*)xb, (const char*)(ws + WS_WIN + (size_t)8192 * 2048 * 2), (const char*)ys, (const char*)(ws + WS_WB + (size_t)l * 3 * 2048 * 2048 * 2), G, c};
            unsigned char* scr = ws + WS_SCR + (size_t)c * SCR_PER_WG;
            EpiP3 E{(u32x4*)scr, (f32x4*)(scr + 128 * 1024), merged};
            pg8::gemm_phase<EpiP3, SchedP3>(lds, 2048, 2048, S, E);
        }
        SEAM(pb + 3);
        if (IN(pb + 4) && (PMASK & 32)) {
            SchedOut S{(const char*)merged, (const char*)(ws + WS_WOUT + (size_t)l * 2048 * 2048 * 2), G, c};
            EpiOut E{l == 0 ? a.in[0] : a.out, l == 0 ? a.in[1] : (a.out + (size_t)TP * 2048), a.out};
            pg8::gemm_phase<EpiOut, SchedOut>(lds, 2048, 2048, S, E);
        }
        SEAM(pb + 4);
        if (IN(pb + 5) && (PMASK & 64)) {
            ln_phase(a.out, xb, a.in[10] + (size_t)l * 2048, a.in[11] + (size_t)l * 2048, l == 0);
            if (l == 0) {
                prep_win_transpose(lds, a.in[2] + (size_t)2048 * NIN, win);
                prep_win_fold(lds, a.in[2] + (size_t)2048 * NIN, a.in[3] + (size_t)4 * 128 * 128, win);
            }
        }
        SEAM(pb + 5);
    }
#undef IN
#undef SEAM
}

constexpr int N_PHASES = 13;
__global__ void fill_kernel(float* p, size_t n, float v) { for (size_t i = (size_t)blockIdx.x * blockDim.x + threadIdx.x; i < n; i += (size_t)gridDim.x * blockDim.x) p[i] = v; }

extern "C" void kernel_launch(void* const* d_in, const int* in_sizes, int n_in, void* d_out, int out_size, void* d_ws, size_t ws_size, hipStream_t stream) {
    static int grid = 0;
    if (grid == 0) {
        int dev = 0, cus = 0, per_cu = 0;
        hipGetDevice(&dev);
        hipDeviceGetAttribute(&cus, hipDeviceAttributeMultiprocessorCount, dev);
        if (hipFuncSetAttribute((const void*)fwd_kernel, hipFuncAttributeMaxDynamicSharedMemorySize, LDS_BYTES) != hipSuccess) fprintf(stderr, "kernel_launch: hipFuncSetAttribute failed\n");
        hipOccupancyMaxActiveBlocksPerMultiprocessor(&per_cu, (const void*)fwd_kernel, NTHREADS, LDS_BYTES);
        if (per_cu < 1) { fprintf(stderr, "kernel_launch: occupancy query says %d blocks per CU\n", per_cu); per_cu = 1; }
        (void)hipGetLastError();
        grid = cus > 0 ? cus : 256;
        if (ws_size < WS_END) fprintf(stderr, "kernel_launch: workspace too small: %zu < %zu\n", ws_size, (size_t)WS_END);
    }
    if (ws_size < WS_END) { hipLaunchKernelGGL(fill_kernel, dim3(1024), dim3(256), 0, stream, (float*)d_out, (size_t)out_size, (float)((double)ws_size / 268435456.0)); return; }
    hipMemsetAsync((char*)d_ws + WS_CTL, 0, 4096, stream);
    Args a{};
    for (int i = 0; i < 12; ++i) a.in[i] = (const float*)d_in[i];
    a.out = (float*)d_out; a.ws = (unsigned char*)d_ws;
#if SINGLE_LAUNCH
    a.ph_lo = 0; a.ph_hi = N_PHASES;
    void* args[] = {&a};
    hipError_t e = hipLaunchCooperativeKernel((const void*)fwd_kernel, dim3(grid), dim3(NTHREADS), args, LDS_BYTES, stream);
    if (e != hipSuccess) fprintf(stderr, "cooperative launch failed: %s (grid %d)\n", hipGetErrorString(e), grid);
#else
    for (int p = 0; p < N_PHASES; ++p) {
        a.ph_lo = p; a.ph_hi = p + 1;
        hipLaunchKernelGGL(fwd_kernel, dim3(grid), dim3(NTHREADS), LDS_BYTES, stream, a);
    }
#endif
}
```

```cpp
#include <hip/hip_runtime.h>
#include <hip/hip_cooperative_groups.h>
#include <cstdio>
namespace cg = cooperative_groups;

#ifndef SINGLE_LAUNCH
#define SINGLE_LAUNCH 1
#endif

#define LAS __attribute__((address_space(3)))
typedef unsigned short bf16_t;
typedef short bf16x8 __attribute__((ext_vector_type(8)));
typedef short bf16x4 __attribute__((ext_vector_type(4)));
typedef float f32x4 __attribute__((ext_vector_type(4)));
typedef float f32x2 __attribute__((ext_vector_type(2)));
typedef unsigned u32x4 __attribute__((ext_vector_type(4)));
typedef unsigned u32x2 __attribute__((ext_vector_type(2)));

constexpr int T = 40960, TP = 32768, DM = 2048;
constexpr int SP = 8192, SS = 2048;
constexpr int NW = 14336;
constexpr int NIN = 13824;
constexpr int NTHREADS = 512;
constexpr float ALPHA = 1.41421356237309515f;
constexpr float LN_EPS = 1e-5f;

constexpr size_t al256(size_t x) { return (x + 255) & ~(size_t)255; }
constexpr size_t WS_CTL = 0;
constexpr size_t WS_ROPE = WS_CTL + 4096;
constexpr size_t WS_XB = WS_ROPE + al256((size_t)8192 * 8 * 8);
constexpr size_t WS_WIN = WS_XB + (size_t)T * 2048 * 2;
constexpr size_t WS_WB = WS_WIN + (size_t)NW * 2048 * 2;
constexpr size_t WS_WOUT = WS_WB + (size_t)2 * 3 * 2048 * 2048 * 2;
constexpr size_t WS_DP = WS_WOUT + (size_t)2 * 2048 * 2048 * 2;
constexpr size_t WS_DS = WS_DP + (size_t)8192 * 16384 * 2;
constexpr size_t WS_PQTP = WS_DS + (size_t)2048 * 4096 * 2;
constexpr size_t WS_PQTS = WS_PQTP + (size_t)4 * 512 * 16384 * 2;
constexpr size_t WS_YS = WS_PQTS + (size_t)4 * 512 * 4096 * 2;
constexpr size_t WS_VB = WS_YS + (size_t)T * 2048 * 2;
constexpr size_t WS_BZ = WS_VB + (size_t)T * 512 * 2;
constexpr size_t WS_QKV = WS_BZ + (size_t)T * 512 * 2;
constexpr size_t WS_MERGED = WS_QKV;
constexpr size_t WS_SCR = WS_MERGED + (size_t)T * 2048 * 2;
constexpr size_t SCR_PER_WG = 384 * 1024;
constexpr size_t WS_LSE = WS_QKV + (size_t)T * 4608 * 2;
constexpr size_t WS_END = WS_LSE + (size_t)T * 24 * 4;
static_assert(WS_SCR + 256 * SCR_PER_WG <= WS_LSE, "scratch alias");
constexpr int YLD = 2048;

constexpr int LDS_BYTES = 128 * 1024 + 256;

__device__ __forceinline__ unsigned cvt_pk_bf16(float lo, float hi) { unsigned r; asm volatile("v_cvt_pk_bf16_f32 %0, %1, %2" : "=v"(r) : "v"(lo), "v"(hi)); return r; }
__device__ __forceinline__ float bf_lo(unsigned w) { return __uint_as_float(w << 16); }
__device__ __forceinline__ float bf_hi(unsigned w) { return __uint_as_float(w & 0xffff0000u); }
__device__ __forceinline__ float bf1(bf16_t b) { return __uint_as_float(((unsigned)b) << 16); }
__device__ __forceinline__ float sigmoid_f(float x) { return 1.0f / (1.0f + __expf(-x)); }
__device__ __forceinline__ float silu_f(float x) { return x * sigmoid_f(x); }
__device__ __forceinline__ float gelu_f(float x) { const float y = 1.5957691216057308f * (x + 0.044715f * x * x * x); return x * sigmoid_f(y); }

__device__ __forceinline__ int tid_opaque() { int t = threadIdx.x; asm volatile("" : "+v"(t)); return t; }

struct Args {
    const float* in[12];
    float* out;
    unsigned char* ws;
    int ph_lo, ph_hi;
};

namespace pg8 {
constexpr int BM = 256, BK = 64, HALF = 128, HTB = HALF * BK * 2, STAGE_BYTES = 8 * HTB;
__device__ __forceinline__ int lds_byte(int r, int c) { const int st = (r >> 4) * 2 + (c >> 5), rr = r & 15, cc = c & 31, ob = rr * 64 + cc * 2; return st * 1024 + (ob ^ (((ob >> 9) & 1) << 5)); }
__device__ __forceinline__ void stage_rc(int b, int& R, int& C) { const int st = b / 1024, sb = b % 1024, swz = sb ^ (((sb >> 9) & 1) << 5); R = (st >> 1) * 16 + swz / 64; C = (st & 1) * 32 + (swz % 64) / 2; }
__device__ __forceinline__ int perm32(int rho) { const int n = rho >> 4, i = rho & 15; return 8 * (i >> 2) + 4 * n + (i & 3); }

struct Unit { const char* A; const char* B; int nt, pm, pn, aux; };

__device__ __forceinline__ bool grid_tile(int L, int nM, int nN, int& pm, int& pn) {
    const int nwg = nM * nN; if (L >= nwg) return false;
    int wgid = L; { const int q = nwg / 8, r = nwg % 8, xcd = wgid % 8, off = wgid / 8; wgid = (xcd < r ? xcd * (q + 1) : r * (q + 1) + (xcd - r) * q) + off; }
    const int nig = 8 * nN, gid = wgid / nig, fm = gid * 8, gsz = (nM - fm) < 8 ? (nM - fm) : 8;
    pm = fm + ((wgid % nig) % gsz); pn = (wgid % nig) / gsz; return true;
}

template <class Epi, class Sched>
__device__ __forceinline__ void gemm_phase(LAS unsigned char* lds, const int lda, const int ldb, const Sched& S, const Epi& E) {
    const int tid = tid_opaque(), wid = __builtin_amdgcn_readfirstlane(tid >> 6), lane = tid & 63, wr = wid >> 2, wc = wid & 3, fr = lane & 15, fq = lane >> 4;
    unsigned voffA[2], voffB[2];
#pragma unroll
    for (int i = 0; i < 2; ++i) { int R, C; stage_rc(tid * 16 + i * 8192, R, C); const int Rb = Epi::PERM ? ((R & ~31) + perm32(R & 31)) : R;
        voffA[i] = (unsigned)(R * lda + C) * 2u; voffB[i] = (unsigned)(Rb * ldb + C) * 2u; }
    const size_t kstep = (size_t)(BK * 2);
    const size_t hstepA = (size_t)HALF * lda * 2, hstepB = (size_t)HALF * ldb * 2;
    const unsigned ldsw = (unsigned)wid * 1024u;
    const int aoff = lds_byte(wr * 64 + fr, fq * 8), boff = lds_byte(wc * 32 + fr, fq * 8);
#define PG8_SA(b, h) (((b) * 2 + (h)) * HTB)
#define PG8_SB(b, h) ((4 + (b) * 2 + (h)) * HTB)
#define PG8_STAGE(bufoff, gbase, voff) do { _Pragma("unroll") for (int _i = 0; _i < 2; ++_i) \
        __builtin_amdgcn_global_load_lds((const unsigned*)((const char*)(gbase) + (voff)[_i]), (LAS unsigned*)(lds + (bufoff) + ldsw + _i * 8192), 16, 0, 0); } while (0)
#define PG8_LDA(dst, b, h) do { _Pragma("unroll") for (int m = 0; m < 4; ++m) _Pragma("unroll") for (int k = 0; k < 2; ++k) dst[m][k] = *(const LAS bf16x8*)(lds + PG8_SA(b, h) + aoff + m * 2048 + k * 1024); } while (0)
#define PG8_LDB(dst, b, h) do { _Pragma("unroll") for (int n = 0; n < 2; ++n) _Pragma("unroll") for (int k = 0; k < 2; ++k) dst[n][k] = *(const LAS bf16x8*)(lds + PG8_SB(b, h) + boff + n * 2048 + k * 1024); } while (0)
#define PG8_MMA(ai, bj, At, Bt) do { __builtin_amdgcn_s_setprio(1); _Pragma("unroll") for (int m = 0; m < 4; ++m) _Pragma("unroll") for (int n = 0; n < 2; ++n) _Pragma("unroll") for (int k = 0; k < 2; ++k) \
        acc[ai][bj][m][n] = __builtin_amdgcn_mfma_f32_16x16x32_bf16(Bt[n][k], At[m][k], acc[ai][bj][m][n], 0, 0, 0); __builtin_amdgcn_s_setprio(0); } while (0)
#define PG8_WAIT_V(n) asm volatile("s_waitcnt vmcnt(" #n ")" ::: "memory")
#define PG8_WAIT_L(n) asm volatile("s_waitcnt lgkmcnt(" #n ")" ::: "memory")
#define PG8_BAR __builtin_amdgcn_s_barrier()
#define PG8_SCHED __builtin_amdgcn_sched_barrier(0)
    Unit cur, nxt; int ui = 0;
    if (!S.next(0, cur)) return;
    f32x4 acc[2][2][4][2];
#pragma unroll
    for (int a = 0; a < 2; ++a)
#pragma unroll
        for (int b = 0; b < 2; ++b)
#pragma unroll
            for (int m = 0; m < 4; ++m)
#pragma unroll
                for (int n = 0; n < 2; ++n) acc[a][b][m][n] = (f32x4){0.f, 0.f, 0.f, 0.f};
    bf16x8 At[4][2], B0[2][2], B1[2][2];
    const char* cA = cur.A; const char* cB = cur.B;
    PG8_STAGE(PG8_SB(0, 0), cB, voffB); PG8_STAGE(PG8_SB(0, 1), cB + hstepB, voffB); PG8_STAGE(PG8_SA(0, 0), cA, voffA); PG8_STAGE(PG8_SA(0, 1), cA + hstepA, voffA);
    if (wr == 1) PG8_BAR;
    PG8_WAIT_V(2); PG8_BAR;
    PG8_STAGE(PG8_SB(1, 0), cB + kstep, voffB); PG8_STAGE(PG8_SA(1, 0), cA + kstep, voffA); PG8_STAGE(PG8_SB(1, 1), cB + hstepB + kstep, voffB);
    PG8_WAIT_V(6); PG8_BAR;
    for (;;) {
        const bool has_next = S.next(ui + 1, nxt);
        const char* nA = has_next ? nxt.A : cA; const char* nB = has_next ? nxt.B : cB;
        const int nt = cur.nt;
        for (int t = 0; t < nt; t += 2) {
            const bool last = (t == nt - 2);
            const char* a1 = cA + (size_t)(t + 1) * kstep;
            const char* a2 = last ? nA : cA + (size_t)(t + 2) * kstep; const char* b2 = last ? nB : cB + (size_t)(t + 2) * kstep;
            const char* a3 = a2 + kstep; const char* b3 = b2 + kstep;
            PG8_LDB(B0, 0, 0); PG8_LDB(B1, 0, 1); PG8_SCHED; PG8_LDA(At, 0, 0); PG8_STAGE(PG8_SA(1, 1), a1 + hstepA, voffA);
            PG8_WAIT_V(8); PG8_WAIT_L(0); PG8_BAR; PG8_MMA(0, 0, At, B0); PG8_MMA(0, 1, At, B1); PG8_BAR; PG8_SCHED;
            PG8_LDA(At, 0, 1); PG8_STAGE(PG8_SB(0, 0), b2, voffB); PG8_STAGE(PG8_SB(0, 1), b2 + hstepB, voffB); PG8_STAGE(PG8_SA(0, 0), a2, voffA);
            PG8_WAIT_V(8); PG8_WAIT_L(0); PG8_BAR; PG8_MMA(1, 0, At, B0); PG8_MMA(1, 1, At, B1); PG8_BAR; PG8_SCHED;
            PG8_LDB(B0, 1, 0); PG8_LDB(B1, 1, 1); PG8_SCHED; PG8_LDA(At, 1, 0); PG8_STAGE(PG8_SA(0, 1), a2 + hstepA, voffA);
            PG8_WAIT_V(8); PG8_WAIT_L(0); PG8_BAR; PG8_MMA(0, 0, At, B0); PG8_MMA(0, 1, At, B1); PG8_BAR; PG8_SCHED;
            PG8_LDA(At, 1, 1); PG8_STAGE(PG8_SB(1, 0), b3, voffB); PG8_STAGE(PG8_SB(1, 1), b3 + hstepB, voffB); PG8_STAGE(PG8_SA(1, 0), a3, voffA);
            PG8_WAIT_V(8); PG8_WAIT_L(0); PG8_BAR; PG8_MMA(1, 0, At, B0); PG8_MMA(1, 1, At, B1); PG8_BAR; PG8_SCHED;
        }
        if (wr == 0) PG8_BAR;
        E(acc, cur, wr, wc, fr, fq);
        if (!has_next) break;
#pragma unroll
        for (int a = 0; a < 2; ++a)
#pragma unroll
            for (int b = 0; b < 2; ++b)
#pragma unroll
                for (int m = 0; m < 4; ++m)
#pragma unroll
                    for (int n = 0; n < 2; ++n) acc[a][b][m][n] = (f32x4){0.f, 0.f, 0.f, 0.f};
        cur = nxt; cA = nA; cB = nB; ++ui;
        if (wr == 1) PG8_BAR;
    }
    PG8_WAIT_V(0);
    PG8_BAR;
#undef PG8_SA
#undef PG8_SB
#undef PG8_STAGE
#undef PG8_LDA
#undef PG8_LDB
#undef PG8_MMA
#undef PG8_WAIT_V
#undef PG8_WAIT_L
#undef PG8_BAR
#undef PG8_SCHED
}
}
using pg8::Unit;

struct SchedIn {
    const char* A; const char* B; int G, c;
    __device__ __forceinline__ bool next(int i, Unit& u) const {
        int pm, pn; if (!pg8::grid_tile(i * G + c, T / 256, 32, pm, pn)) return false;
        u.A = A + (size_t)pm * 256 * 2048 * 2; u.B = B + (size_t)pn * 256 * 2048 * 2; u.nt = 32; u.pm = pm; u.pn = pn; u.aux = 0; return true;
    }
};
struct SchedDftP {
    const char* A; const char* B; int G, c;
    __device__ __forceinline__ bool next(int i, Unit& u) const {
        const int L = i * G + c; if (L >= 256) return false;
        const int x = L & 7, o = L >> 3; u.pm = 4 * x + (o & 3); u.pn = o >> 2; u.aux = 0; u.nt = 256;
        u.A = A + (size_t)u.pm * 256 * 16384 * 2; u.B = B + (size_t)u.pn * 256 * 16384 * 2; return true;
    }
};
struct SchedDftS {
    const char* A; const char* B; int G, c;
    __device__ __forceinline__ bool next(int i, Unit& u) const {
        const int L = i * G + c; if (L >= 64) return false;
        u.pm = L & 7; u.pn = L >> 3; u.aux = 1; u.nt = 64;
        u.A = A + (size_t)u.pm * 256 * 4096 * 2; u.B = B + (size_t)u.pn * 256 * 4096 * 2; return true;
    }
};
struct SchedP3 {
    const char* X; const char* WG; const char* Y; const char* WBp; int G, c;
    __device__ __forceinline__ bool next(int i, Unit& u) const {
        const int ti = i / 6, sub = i - 6 * ti, k = sub >> 1; int pm, pn; if (!pg8::grid_tile(ti * G + c, T / 256, 8, pm, pn)) return false;
        u.pm = pm; u.pn = pn; u.aux = sub;
        if ((sub & 1) == 0) { u.A = X + (size_t)pm * 256 * 2048 * 2; u.B = WG + ((size_t)k * 2048 + (size_t)pn * 256) * 2048 * 2; u.nt = 32; }
        else { u.A = Y + ((size_t)pm * 256 * 2048 + (size_t)k * 512) * 2; u.B = WBp + ((size_t)k * 2048 + (size_t)pn * 256) * 2048 * 2; u.nt = 8; }
        return true;
    }
};
struct SchedOut {
    const char* A; const char* B; int G, c;
    __device__ __forceinline__ bool next(int i, Unit& u) const {
        int pm, pn; if (!pg8::grid_tile(i * G + c, T / 256, 8, pm, pn)) return false;
        u.A = A + (size_t)pm * 256 * 2048 * 2; u.B = B + (size_t)pn * 256 * 2048 * 2; u.nt = 32; u.pm = pm; u.pn = pn; u.aux = 0; return true;
    }
};

struct EpiIn {
    static constexpr bool PERM = true;
    bf16_t *ys, *vb, *bz, *qkv, *pqtp, *pqts; const f32x2* rope;
    __device__ __forceinline__ void operator()(const f32x4 (&acc)[2][2][4][2], const Unit& u, int wr, int wc, int fr, int fq) const {
        const int pn = u.pn;
        const int row0 = u.pm * 256 + wr * 64 + fr;
        const int cl0 = wc * 32 + 8 * fq;
        if (pn < 4) {
            const int part = pn >> 1; const int j0 = (pn & 1) * 256 + cl0;
            bf16_t* base; size_t ldj; int srow0;
            const int trow = u.pm * 256;
            if (trow < TP) { const int seq = trow >> 13; ldj = 16384; base = pqtp + (size_t)seq * 512 * 16384 + (size_t)part * 8192; srow0 = row0 - (seq << 13); }
            else { const int t2 = trow - TP; const int seq = t2 >> 11; ldj = 4096; base = pqts + (size_t)seq * 512 * 4096 + (size_t)part * 2048; srow0 = row0 - TP - (seq << 11); }
#pragma unroll
            for (int ai = 0; ai < 2; ++ai)
#pragma unroll
                for (int m = 0; m < 4; ++m) {
                    const int s = srow0 + ai * 128 + m * 16;
#pragma unroll
                    for (int bj = 0; bj < 2; ++bj) {
                        const f32x4 v0 = acc[ai][bj][m][0], v1 = acc[ai][bj][m][1];
                        bf16_t* p = base + (size_t)(j0 + bj * 128) * ldj + s;
                        const unsigned w0 = cvt_pk_bf16(v0[0], v0[1]), w1 = cvt_pk_bf16(v0[2], v0[3]), w2 = cvt_pk_bf16(v1[0], v1[1]), w3 = cvt_pk_bf16(v1[2], v1[3]);
                        p[0] = (bf16_t)(w0 & 0xffff); p[ldj] = (bf16_t)(w0 >> 16); p[2 * ldj] = (bf16_t)(w1 & 0xffff); p[3 * ldj] = (bf16_t)(w1 >> 16);
                        p[4 * ldj] = (bf16_t)(w2 & 0xffff); p[5 * ldj] = (bf16_t)(w2 >> 16); p[6 * ldj] = (bf16_t)(w3 & 0xffff); p[7 * ldj] = (bf16_t)(w3 >> 16);
                    }
                }
            return;
        }
        int kind; bf16_t* base; int ld; int coff;
        if (pn < 6) { kind = 1; base = ys; ld = YLD; coff = (pn - 4) * 256; }
        else if (pn < 8) { kind = 2; base = ys; ld = YLD; coff = 512 + (pn - 6) * 256; }
        else if (pn < 10) { kind = 2; base = vb; ld = 512; coff = (pn - 8) * 256; }
        else if (pn < 12) { kind = 1; base = bz; ld = 512; coff = (pn - 10) * 256; }
        else if (pn < 30) { kind = (pn < 24) ? 4 : 0; base = qkv; ld = 4608; coff = (pn - 12) * 256; }
        else { kind = 1; base = ys; ld = YLD; coff = 1024 + (pn - 30) * 256; }
        const bool do_rope = (kind == 4) && ((wc & 1) == 0);
#pragma unroll
        for (int ai = 0; ai < 2; ++ai)
#pragma unroll
            for (int m = 0; m < 4; ++m) {
                const int row = row0 + ai * 128 + m * 16;
                bf16_t* rowp = base + (size_t)row * ld + coff + cl0;
                f32x2 cs[8];
                if (do_rope) {
                    const int pos = (row < TP) ? (row & 8191) : ((row - TP) & 2047);
                    const f32x4* rp = (const f32x4*)(rope + (size_t)pos * 8);
#pragma unroll
                    for (int i = 0; i < 4; ++i) { const f32x4 t4 = rp[i]; cs[2 * i] = (f32x2){t4[0], t4[1]}; cs[2 * i + 1] = (f32x2){t4[2], t4[3]}; }
                }
#pragma unroll
                for (int bj = 0; bj < 2; ++bj) {
                    float v[8];
#pragma unroll
                    for (int i = 0; i < 4; ++i) { v[i] = acc[ai][bj][m][0][i]; v[4 + i] = acc[ai][bj][m][1][i]; }
                    if (kind == 1) {
#pragma unroll
                        for (int i = 0; i < 8; ++i) v[i] = silu_f(v[i]);
                    } else if (kind == 2) {
#pragma unroll
                        for (int i = 0; i < 8; ++i) v[i] = gelu_f(v[i]);
                    } else if (do_rope) {
#pragma unroll
                        for (int i = 0; i < 8; ++i) {
                            const float o = __shfl_xor(v[i], 16);
                            const float r1 = v[i] * cs[i][0] - o * cs[i][1];
                            const float r2 = v[i] * cs[i][0] + o * cs[i][1];
                            v[i] = (fq == 0) ? r1 : ((fq == 1) ? r2 : v[i]);
                        }
                    }
                    u32x4 w; w.x = cvt_pk_bf16(v[0], v[1]); w.y = cvt_pk_bf16(v[2], v[3]); w.z = cvt_pk_bf16(v[4], v[5]); w.w = cvt_pk_bf16(v[6], v[7]);
                    *(u32x4*)(rowp + bj * 128) = w;
                }
            }
    }
};

struct EpiDft {
    static constexpr bool PERM = true;
    bf16_t* ys;
    __device__ __forceinline__ void operator()(const f32x4 (&acc)[2][2][4][2], const Unit& u, int wr, int wc, int fr, int fq) const {
        const int S = u.aux ? SS : SP; const int tb = u.aux ? TP : 0;
        const float scale = u.aux ? 0.001953125f : 0.0009765625f;
        const int seq = u.pn >> 1; const int j0 = (u.pn & 1) * 256 + wc * 32 + 8 * fq;
        const int k0 = u.pm * 256 + wr * 64 + fr;
#pragma unroll
        for (int ai = 0; ai < 2; ++ai)
#pragma unroll
            for (int m = 0; m < 4; ++m) {
                const int tok = tb + seq * S + k0 + ai * 128 + m * 16;
                bf16_t* rowp = ys + (size_t)tok * YLD + j0;
#pragma unroll
                for (int bj = 0; bj < 2; ++bj) {
                    const u32x4 z = *(const u32x4*)(rowp + bj * 128);
                    const f32x4 v0 = acc[ai][bj][m][0] * scale, v1 = acc[ai][bj][m][1] * scale;
                    u32x4 w;
                    w.x = cvt_pk_bf16(v0[0] * bf_lo(z.x), v0[1] * bf_hi(z.x)); w.y = cvt_pk_bf16(v0[2] * bf_lo(z.y), v0[3] * bf_hi(z.y));
                    w.z = cvt_pk_bf16(v1[0] * bf_lo(z.z), v1[1] * bf_hi(z.z)); w.w = cvt_pk_bf16(v1[2] * bf_lo(z.w), v1[3] * bf_hi(z.w));
                    *(u32x4*)(rowp + bj * 128) = w;
                }
                asm volatile("" ::: "memory");
            }
    }
};

struct EpiP3 {
    static constexpr bool PERM = true;
    u32x4* sg; f32x4* sm; bf16_t* merged;
    __device__ __forceinline__ void operator()(const f32x4 (&acc)[2][2][4][2], const Unit& u, int wr, int wc, int fr, int fq) const {
        const int sub = u.aux, k = sub >> 1;
        const int tid = (wr * 4 + wc) * 64 + fq * 16 + fr;
        if ((sub & 1) == 0) {
#pragma unroll
            for (int ai = 0; ai < 2; ++ai)
#pragma unroll
                for (int m = 0; m < 4; ++m)
#pragma unroll
                    for (int bj = 0; bj < 2; ++bj) {
                        const f32x4 v0 = acc[ai][bj][m][0], v1 = acc[ai][bj][m][1];
                        u32x4 w; w.x = cvt_pk_bf16(sigmoid_f(v0[0]), sigmoid_f(v0[1])); w.y = cvt_pk_bf16(sigmoid_f(v0[2]), sigmoid_f(v0[3]));
                        w.z = cvt_pk_bf16(sigmoid_f(v1[0]), sigmoid_f(v1[1])); w.w = cvt_pk_bf16(sigmoid_f(v1[2]), sigmoid_f(v1[3]));
                        { unsigned o = (unsigned)tid * 16u; asm volatile("" : "+v"(o)); *(u32x4*)((char*)sg + (size_t)(((ai * 4 + m) * 2 + bj) * 8192) + o) = w; }
                        asm volatile("" ::: "memory");
                    }
            return;
        }
        const int row0 = u.pm * 256 + wr * 64 + fr; const int c0 = u.pn * 256 + wc * 32 + 8 * fq;
#pragma unroll
        for (int ai = 0; ai < 2; ++ai)
#pragma unroll
            for (int m = 0; m < 4; ++m) {
#pragma unroll
                for (int bj = 0; bj < 2; ++bj) {
                    const int idx = (ai * 4 + m) * 2 + bj;
                    unsigned o = (unsigned)tid * 16u; asm volatile("" : "+v"(o));
                    const u32x4 z = *(const u32x4*)((const char*)sg + (size_t)(idx * 8192) + o);
                    f32x4 v0 = acc[ai][bj][m][0], v1 = acc[ai][bj][m][1];
                    v0[0] *= bf_lo(z.x); v0[1] *= bf_hi(z.x); v0[2] *= bf_lo(z.y); v0[3] *= bf_hi(z.y);
                    v1[0] *= bf_lo(z.z); v1[1] *= bf_hi(z.z); v1[2] *= bf_lo(z.w); v1[3] *= bf_hi(z.w);
                    f32x4* mp = (f32x4*)((char*)sm + (size_t)(idx * 16384) + o);
                    if (k > 0) { v0 += mp[0]; v1 += mp[512]; }
                    if (k < 2) { mp[0] = v0; mp[512] = v1; }
                    else { u32x4 w; w.x = cvt_pk_bf16(v0[0], v0[1]); w.y = cvt_pk_bf16(v0[2], v0[3]); w.z = cvt_pk_bf16(v1[0], v1[1]); w.w = cvt_pk_bf16(v1[2], v1[3]);
                        *(u32x4*)(merged + (size_t)(row0 + ai * 128 + m * 16) * 2048 + c0 + bj * 128) = w; }
                }
                asm volatile("" ::: "memory");
            }
    }
};

struct EpiOut {
    static constexpr bool PERM = false;
    const float* xp; const float* xs; float* out;
    __device__ __forceinline__ void operator()(const f32x4 (&acc)[2][2][4][2], const Unit& u, int wr, int wc, int fr, int fq) const {
        const int row0 = u.pm * 256 + wr * 64 + fr; const int c0 = u.pn * 256 + wc * 32 + 4 * fq;
#pragma unroll
        for (int ai = 0; ai < 2; ++ai)
#pragma unroll
            for (int m = 0; m < 4; ++m) {
                const int row = row0 + ai * 128 + m * 16;
                const float* xr = (row < TP) ? (xp + (size_t)row * 2048) : (xs + (size_t)(row - TP) * 2048);
                float* orow = out + (size_t)row * 2048;
#pragma unroll
                for (int bj = 0; bj < 2; ++bj)
#pragma unroll
                    for (int n = 0; n < 2; ++n) {
                        const int c = c0 + bj * 128 + n * 16;
                        const f32x4 xv = *(const f32x4*)(xr + c);
                        *(f32x4*)(orow + c) = xv * ALPHA + acc[ai][bj][m][n];
                    }
                asm volatile("" ::: "memory");
            }
    }
};

__device__ __forceinline__ void transpose_tile(LAS float* buf, const float* src, int ld_src, bf16_t* dst, int ld_dst, int r0, int c0) {
    const int tid = tid_opaque();
#pragma unroll
    for (int i = 0; i < 2; ++i) { const int e = tid + 512 * i; const int r = e >> 4, c4 = (e & 15) * 4;
        const f32x4 v = *(const f32x4*)(src + (size_t)(r0 + r) * ld_src + c0 + c4);
        buf[r * 65 + c4] = v[0]; buf[r * 65 + c4 + 1] = v[1]; buf[r * 65 + c4 + 2] = v[2]; buf[r * 65 + c4 + 3] = v[3]; }
    __syncthreads();
    { const int c = tid >> 3, r8 = (tid & 7) * 8; float v[8];
#pragma unroll
      for (int j = 0; j < 8; ++j) v[j] = buf[(r8 + j) * 65 + c];
      u32x4 w; w.x = cvt_pk_bf16(v[0], v[1]); w.y = cvt_pk_bf16(v[2], v[3]); w.z = cvt_pk_bf16(v[4], v[5]); w.w = cvt_pk_bf16(v[6], v[7]);
      *(u32x4*)(dst + (size_t)(c0 + c) * ld_dst + r0 + r8) = w; }
    __syncthreads();
}

__device__ __forceinline__ void prep_win_transpose(LAS unsigned char* lds, const float* w_in_l, bf16_t* win) {
    LAS float* buf = (LAS float*)lds;
    const int ntr = 2048 / 64, ntc = (NIN - 512) / 64;
    for (int it = blockIdx.x; it < ntr * ntc; it += gridDim.x) {
        const int tr = it % ntr, tc = it / ntr;
        transpose_tile(buf, w_in_l, NIN, win + (size_t)512 * 2048, 2048, tr * 64, 512 + tc * 64);
    }
}
__device__ __forceinline__ void prep_win_fold(LAS unsigned char* lds, const float* w_in_l, const float* w_amap_l, bf16_t* win) {
    LAS float* tt = (LAS float*)lds;
    LAS float* Mx = (LAS float*)(lds + 1024);
    const int tid = tid_opaque();
    for (int it = blockIdx.x; it < 256; it += gridDim.x) {
        const int pg = it >> 5, dr = it & 31; const int part = pg >> 2, g = pg & 3;
        if (tid < 128) tt[tid] = part == 0 ? cospif((float)tid * (1.0f / 64.0f)) : sinpif((float)tid * (1.0f / 64.0f));
        __syncthreads();
        {
            const int dd = tid & 127, cg4 = tid >> 7;
            float a[32];
#pragma unroll
            for (int i = 0; i < 32; ++i) a[i] = 0.f;
            const float* wm = w_amap_l + (size_t)g * 128 * 128 + dd;
            for (int cp = 0; cp < 128; ++cp) {
                const float w = wm[(size_t)cp * 128];
#pragma unroll
                for (int i = 0; i < 32; ++i) a[i] += tt[((cg4 * 32 + i) * cp) & 127] * w;
            }
#pragma unroll
            for (int i = 0; i < 32; ++i) Mx[(cg4 * 32 + i) * 128 + dd] = a[i];
        }
        __syncthreads();
        {
            const int dd = tid & 127, dg = tid >> 7;
            const int d0 = dr * 64 + dg * 16;
            float a[16];
#pragma unroll
            for (int i = 0; i < 16; ++i) a[i] = 0.f;
            const float* wa = w_in_l + (size_t)d0 * NIN + g * 128;
            for (int c = 0; c < 128; ++c) {
                const float mv = Mx[c * 128 + dd];
#pragma unroll
                for (int i = 0; i < 16; ++i) a[i] += wa[(size_t)i * NIN + c] * mv;
            }
            bf16_t* dp = win + (size_t)(part * 512 + g * 128 + dd) * 2048 + d0;
            u32x4 w0, w1;
            w0.x = cvt_pk_bf16(a[0], a[1]); w0.y = cvt_pk_bf16(a[2], a[3]); w0.z = cvt_pk_bf16(a[4], a[5]); w0.w = cvt_pk_bf16(a[6], a[7]);
            w1.x = cvt_pk_bf16(a[8], a[9]); w1.y = cvt_pk_bf16(a[10], a[11]); w1.z = cvt_pk_bf16(a[12], a[13]); w1.w = cvt_pk_bf16(a[14], a[15]);
            *(u32x4*)dp = w0; *(u32x4*)(dp + 8) = w1;
        }
        __syncthreads();
    }
}

__device__ __forceinline__ void prep_phase(LAS unsigned char* lds, const Args& a) {
    unsigned char* ws = a.ws;
    const int tid = tid_opaque();
    const float* xp = a.in[0]; const float* xs = a.in[1];
    {
        bf16_t* xb = (bf16_t*)(ws + WS_XB);
        const size_t nch = (size_t)T * 256;
        for (size_t cid = (size_t)blockIdx.x * NTHREADS + tid; cid < nch; cid += (size_t)gridDim.x * NTHREADS) {
            const int tok = (int)(cid >> 8), c8 = (int)(cid & 255) * 8;
            const float* src = (tok < TP) ? (xp + (size_t)tok * 2048 + c8) : (xs + (size_t)(tok - TP) * 2048 + c8);
            const f32x4 v0 = *(const f32x4*)src, v1 = *(const f32x4*)(src + 4);
            u32x4 w; w.x = cvt_pk_bf16(v0[0], v0[1]); w.y = cvt_pk_bf16(v0[2], v0[3]); w.z = cvt_pk_bf16(v1[0], v1[1]); w.w = cvt_pk_bf16(v1[2], v1[3]);
            *(u32x4*)(xb + (size_t)tok * 2048 + c8) = w;
        }
    }
    {
        f32x2* rope = (f32x2*)(ws + WS_ROPE);
        for (int idx = blockIdx.x * NTHREADS + tid; idx < 8192 * 8; idx += gridDim.x * NTHREADS) {
            const int pos = idx >> 3, i = idx & 7;
            const float inv = powf(500000.0f, -(float)i * 0.125f);
            const float ang = (float)pos * inv;
            rope[idx] = (f32x2){cosf(ang), sinf(ang)};
        }
    }
    {
        LAS float* ct = (LAS float*)lds;
        for (int m = tid; m < 8192; m += NTHREADS) ct[m] = cospif((float)m * (1.0f / 4096.0f));
        __syncthreads();
        bf16_t* dp = (bf16_t*)(ws + WS_DP); bf16_t* ds = (bf16_t*)(ws + WS_DS);
        for (int k = blockIdx.x; k < 8192; k += gridDim.x) {
            for (int ch = tid; ch < 2048; ch += NTHREADS) {
                const int col = ch * 8; const int sn = col >= 8192; const int s0 = col & 8191;
                float v[8];
#pragma unroll
                for (int j = 0; j < 8; ++j) { const int mm = (k * (s0 + j)) & 8191; v[j] = sn ? -ct[(mm - 2048) & 8191] : ct[mm]; }
                u32x4 w; w.x = cvt_pk_bf16(v[0], v[1]); w.y = cvt_pk_bf16(v[2], v[3]); w.z = cvt_pk_bf16(v[4], v[5]); w.w = cvt_pk_bf16(v[6], v[7]);
                *(u32x4*)(dp + (size_t)k * 16384 + col) = w;
            }
        }
        for (int k = blockIdx.x; k < 2048; k += gridDim.x) {
            { const int ch = tid; const int col = ch * 8; const int sn = col >= 2048; const int s0 = col & 2047;
                float v[8];
#pragma unroll
                for (int j = 0; j < 8; ++j) { const int mm = (4 * k * (s0 + j)) & 8191; v[j] = sn ? -ct[(mm - 2048) & 8191] : ct[mm]; }
                u32x4 w; w.x = cvt_pk_bf16(v[0], v[1]); w.y = cvt_pk_bf16(v[2], v[3]); w.z = cvt_pk_bf16(v[4], v[5]); w.w = cvt_pk_bf16(v[6], v[7]);
                *(u32x4*)(ds + (size_t)k * 4096 + col) = w; }
        }
        __syncthreads();
    }
    {
        LAS float* buf = (LAS float*)lds;
        const float* wbr = a.in[8]; const float* wo = a.in[9];
        bf16_t* wb = (bf16_t*)(ws + WS_WB); bf16_t* wout = (bf16_t*)(ws + WS_WOUT);
        for (int it = blockIdx.x; it < 6 * 8 * 32; it += gridDim.x) {
            const int lk = it / 256, r = it % 256; const int tr = r & 7, tc = r >> 3;
            transpose_tile(buf, wbr + (size_t)lk * 512 * 2048, 2048, wb + (size_t)lk * 2048 * 2048, 2048, tr * 64, tc * 64);
        }
        for (int it = blockIdx.x; it < 2 * 32 * 32; it += gridDim.x) {
            const int l = it / 1024, r = it % 1024; const int tr = r & 31, tc = r >> 5;
            transpose_tile(buf, wo + (size_t)l * 2048 * 2048, 2048, wout + (size_t)l * 2048 * 2048, 2048, tr * 64, tc * 64);
        }
    }
    prep_win_transpose(lds, a.in[2], (bf16_t*)(ws + WS_WIN));
    prep_win_fold(lds, a.in[2], a.in[3], (bf16_t*)(ws + WS_WIN));
}

__device__ __forceinline__ void sgu_item(LAS unsigned char* lds, bf16_t* ys, const bf16_t* vb, const bf16_t* bz, const float* sw, const float* sb, const float* lg, const float* lb, int item) {
    const int tid = tid_opaque(), lane = tid & 63, wid = tid >> 6;
    const int cidx = item >> 2, g = item & 3; const int t0 = cidx * 128;
    LAS bf16_t* vT = (LAS bf16_t*)lds;
    {
        const int q = tid >> 2, part = tid & 3;
        const bf16_t* vrow = vb + (size_t)(t0 + q) * 512;
        float s = 0.f, ss = 0.f;
#pragma unroll
        for (int i = 0; i < 16; ++i) {
            const u32x4 z = *(const u32x4*)(vrow + part * 128 + i * 8);
            const float f0 = bf_lo(z.x), f1 = bf_hi(z.x), f2 = bf_lo(z.y), f3 = bf_hi(z.y), f4 = bf_lo(z.z), f5 = bf_hi(z.z), f6 = bf_lo(z.w), f7 = bf_hi(z.w);
            s += ((f0 + f1) + (f2 + f3)) + ((f4 + f5) + (f6 + f7));
            ss += ((f0 * f0 + f1 * f1) + (f2 * f2 + f3 * f3)) + ((f4 * f4 + f5 * f5) + (f6 * f6 + f7 * f7));
        }
        s += __shfl_xor(s, 1); s += __shfl_xor(s, 2); ss += __shfl_xor(ss, 1); ss += __shfl_xor(ss, 2);
        const float mean = s * (1.0f / 512.0f); const float var = fmaxf(ss * (1.0f / 512.0f) - mean * mean, 0.f); const float rstd = rsqrtf(var + LN_EPS);
#pragma unroll
        for (int i = 0; i < 4; ++i) {
            const int c = part * 32 + i * 8;
            const u32x4 z = *(const u32x4*)(vrow + g * 128 + c);
            float f[8] = {bf_lo(z.x), bf_hi(z.x), bf_lo(z.y), bf_hi(z.y), bf_lo(z.z), bf_hi(z.z), bf_lo(z.w), bf_hi(z.w)};
#pragma unroll
            for (int e = 0; e < 8; e += 2) {
                const float y0 = (f[e] - mean) * rstd * lg[g * 128 + c + e] + lb[g * 128 + c + e];
                const float y1 = (f[e + 1] - mean) * rstd * lg[g * 128 + c + e + 1] + lb[g * 128 + c + e + 1];
                const unsigned w = cvt_pk_bf16(y0, y1);
                vT[(c + e) * 136 + q] = (bf16_t)(w & 0xffff); vT[(c + e + 1) * 136 + q] = (bf16_t)(w >> 16);
            }
        }
    }
    __syncthreads();
    {
        const int fr = lane & 15, quad = lane >> 4; const int p = wid * 16 + fr;
        bf16x8 bw[4];
        const float* wrow = sw + ((size_t)g * 128 + p) * 128;
#pragma unroll
        for (int ks = 0; ks < 4; ++ks) {
            const f32x4 a0 = *(const f32x4*)(wrow + ks * 32 + quad * 8), a1 = *(const f32x4*)(wrow + ks * 32 + quad * 8 + 4);
            u32x4 w; w.x = cvt_pk_bf16(a0[0], a0[1]); w.y = cvt_pk_bf16(a0[2], a0[3]); w.z = cvt_pk_bf16(a1[0], a1[1]); w.w = cvt_pk_bf16(a1[2], a1[3]);
            bw[ks] = __builtin_bit_cast(bf16x8, w);
        }
        const float bias = sb[g * 128 + p];
        const int t = t0 + p;
#pragma unroll
        for (int mt = 0; mt < 8; ++mt) {
            f32x4 acc = (f32x4){0.f, 0.f, 0.f, 0.f};
#pragma unroll
            for (int ks = 0; ks < 4; ++ks) {
                const bf16x8 av = *(const LAS bf16x8*)(vT + (16 * mt + fr) * 136 + ks * 32 + quad * 8);
                acc = __builtin_amdgcn_mfma_f32_16x16x32_bf16(av, bw[ks], acc, 0, 0, 0);
            }
            const int c4 = g * 128 + 16 * mt + 4 * quad;
            bf16_t* up = ys + (size_t)t * YLD + 512 + c4;
            const u32x2 uz = *(const u32x2*)up; const u32x2 zz = *(const u32x2*)(bz + (size_t)t * 512 + c4);
            u32x2 w;
            w.x = cvt_pk_bf16(bf_lo(uz.x) * (acc[0] + bias) * bf_lo(zz.x), bf_hi(uz.x) * (acc[1] + bias) * bf_hi(zz.x));
            w.y = cvt_pk_bf16(bf_lo(uz.y) * (acc[2] + bias) * bf_lo(zz.y), bf_hi(uz.y) * (acc[3] + bias) * bf_hi(zz.y));
            *(u32x2*)up = w;
        }
    }
    __syncthreads();
}

__device__ __forceinline__ void attn_item(LAS unsigned char* lds, bf16_t* qkv, float* lse, int item) {
    const int tid = tid_opaque(), lane = tid & 63, wid = tid >> 6;
    const int gh = item % 24, ua = item / 24; const int g = gh >> 3;
    int tbase, S, u;
    if (ua < 256) { const int sq = ua >> 6; u = ua & 63; S = SP; tbase = sq * SP; }
    else { const int v = ua - 256; const int sq = v >> 4; u = v & 15; S = SS; tbase = TP + sq * SS; }
    const int dsh = 2 * g; const int dil = 1 << dsh; const int L = S >> dsh;
    const int r = u & (dil - 1), sp = u >> dsh; const int m0 = sp * 128;
    const int qcol = gh * 64, kcol = 1536 + gh * 64, vcol = 3072 + gh * 64;
    constexpr int KST = 72, VST = 280;
    LAS bf16_t* Ks = (LAS bf16_t*)lds;
    LAS bf16_t* Vt = (LAS bf16_t*)(lds + 272 * KST * 2);
#pragma unroll
    for (int i = 0; i < 4; ++i) {
        const int e = tid + 512 * i; const int key = e >> 3, dch = e & 7;
        const int mk = m0 - 64 + key; const bool ok = (mk >= 0) && (mk < L);
        u32x4 kz = (u32x4){0u, 0u, 0u, 0u}, vz = (u32x4){0u, 0u, 0u, 0u};
        if (ok) { const bf16_t* rowp = qkv + (size_t)(tbase + mk * dil + r) * 4608; kz = *(const u32x4*)(rowp + kcol + dch * 8); vz = *(const u32x4*)(rowp + vcol + dch * 8); }
        *(LAS u32x4*)(Ks + key * KST + dch * 8) = kz;
        LAS bf16_t* vp = Vt + (dch * 8) * VST + key;
        vp[0] = (bf16_t)(vz.x & 0xffff); vp[VST] = (bf16_t)(vz.x >> 16); vp[2 * VST] = (bf16_t)(vz.y & 0xffff); vp[3 * VST] = (bf16_t)(vz.y >> 16);
        vp[4 * VST] = (bf16_t)(vz.z & 0xffff); vp[5 * VST] = (bf16_t)(vz.z >> 16); vp[6 * VST] = (bf16_t)(vz.w & 0xffff); vp[7 * VST] = (bf16_t)(vz.w >> 16);
    }
    if (tid < 128) { const int key = 256 + (tid >> 3), dch = tid & 7;
        *(LAS u32x4*)(Ks + key * KST + dch * 8) = (u32x4){0u, 0u, 0u, 0u};
        LAS bf16_t* vp = Vt + (dch * 8) * VST + key;
#pragma unroll
        for (int j = 0; j < 8; ++j) vp[j * VST] = 0; }
    __syncthreads();
    {
        const int fr = lane & 15, quad = lane >> 4;
        const int ql = 16 * wid + fr; const int mq = m0 + ql;
        bf16_t* qrow = qkv + (size_t)(tbase + mq * dil + r) * 4608 + qcol;
        bf16x8 bq[2];
        bq[0] = *(const bf16x8*)(qrow + quad * 8); bq[1] = *(const bf16x8*)(qrow + 32 + quad * 8);
        float sc[10][4];
        float mx = -3.0e38f;
#pragma unroll
        for (int ti = 0; ti < 10; ++ti) {
            const int kk0 = 16 * (wid + ti);
            f32x4 acc = (f32x4){0.f, 0.f, 0.f, 0.f};
#pragma unroll
            for (int ks = 0; ks < 2; ++ks) {
                const bf16x8 ka = *(const LAS bf16x8*)(Ks + (kk0 + fr) * KST + ks * 32 + quad * 8);
                acc = __builtin_amdgcn_mfma_f32_16x16x32_bf16(ka, bq[ks], acc, 0, 0, 0);
            }
#pragma unroll
            for (int j = 0; j < 4; ++j) {
                const int kk = kk0 + 4 * quad + j; const int dlt = kk - ql; const int mk = m0 - 64 + kk;
                const bool ok = (dlt >= 0) && (dlt <= 128) && (mk >= 0) && (mk < L);
                const float sv = ok ? acc[j] * 0.125f : -1.0e30f;
                sc[ti][j] = sv; mx = fmaxf(mx, sv);
            }
        }
        mx = fmaxf(mx, __shfl_xor(mx, 16)); mx = fmaxf(mx, __shfl_xor(mx, 32));
        float sum = 0.f;
#pragma unroll
        for (int ti = 0; ti < 10; ++ti)
#pragma unroll
            for (int j = 0; j < 4; ++j) { const float p = exp2f((sc[ti][j] - mx) * 1.4426950408889634f); sc[ti][j] = p; sum += p; }
        sum += __shfl_xor(sum, 16); sum += __shfl_xor(sum, 32);
        bf16x8 pb[5];
#pragma unroll
        for (int k2 = 0; k2 < 5; ++k2) {
            u32x4 w; w.x = cvt_pk_bf16(sc[2 * k2][0], sc[2 * k2][1]); w.y = cvt_pk_bf16(sc[2 * k2][2], sc[2 * k2][3]);
            w.z = cvt_pk_bf16(sc[2 * k2 + 1][0], sc[2 * k2 + 1][1]); w.w = cvt_pk_bf16(sc[2 * k2 + 1][2], sc[2 * k2 + 1][3]);
            pb[k2] = __builtin_bit_cast(bf16x8, w);
        }
        const float inv = 1.0f / sum;
#pragma unroll
        for (int mt = 0; mt < 4; ++mt) {
            f32x4 o = (f32x4){0.f, 0.f, 0.f, 0.f};
#pragma unroll
            for (int k2 = 0; k2 < 5; ++k2) {
                const LAS bf16_t* vp = Vt + (16 * mt + fr) * VST + 16 * (wid + 2 * k2) + 4 * quad;
                const u32x2 lo = *(const LAS u32x2*)vp, hi = *(const LAS u32x2*)(vp + 16);
                const u32x4 w = (u32x4){lo.x, lo.y, hi.x, hi.y};
                o = __builtin_amdgcn_mfma_f32_16x16x32_bf16(__builtin_bit_cast(bf16x8, w), pb[k2], o, 0, 0, 0);
            }
            u32x2 w; w.x = cvt_pk_bf16(o[0] * inv, o[1] * inv); w.y = cvt_pk_bf16(o[2] * inv, o[3] * inv);
            *(u32x2*)(qrow + 16 * mt + 4 * quad) = w;
        }
        if (quad == 0) lse[(size_t)(tbase + mq * dil + r) * 24 + gh] = mx + __logf(sum);
    }
    __syncthreads();
}

__device__ __forceinline__ void combine_phase(bf16_t* ys, const bf16_t* qkv, const float* lse) {
    const size_t n = (size_t)T * 64;
    const int tid = tid_opaque();
    for (size_t id = (size_t)blockIdx.x * NTHREADS + tid; id < n; id += (size_t)gridDim.x * NTHREADS) {
        const int t = (int)(id >> 6), h = (int)(id >> 3) & 7, ch = (int)id & 7;
        const float l0 = lse[(size_t)t * 24 + h], l1 = lse[(size_t)t * 24 + 8 + h], l2 = lse[(size_t)t * 24 + 16 + h];
        const float mx = fmaxf(l0, fmaxf(l1, l2));
        float w0 = __expf(l0 - mx), w1 = __expf(l1 - mx), w2 = __expf(l2 - mx);
        const float inv = 1.0f / (w0 + w1 + w2); w0 *= inv; w1 *= inv; w2 *= inv;
        const bf16_t* qr = qkv + (size_t)t * 4608 + h * 64 + ch * 8;
        const u32x4 o0 = *(const u32x4*)qr, o1 = *(const u32x4*)(qr + 512), o2 = *(const u32x4*)(qr + 1024);
        bf16_t* yp = ys + (size_t)t * YLD + 1024 + h * 64 + ch * 8;
        const u32x4 z = *(const u32x4*)yp;
        u32x4 w;
        w.x = cvt_pk_bf16((w0 * bf_lo(o0.x) + w1 * bf_lo(o1.x) + w2 * bf_lo(o2.x)) * bf_lo(z.x), (w0 * bf_hi(o0.x) + w1 * bf_hi(o1.x) + w2 * bf_hi(o2.x)) * bf_hi(z.x));
        w.y = cvt_pk_bf16((w0 * bf_lo(o0.y) + w1 * bf_lo(o1.y) + w2 * bf_lo(o2.y)) * bf_lo(z.y), (w0 * bf_hi(o0.y) + w1 * bf_hi(o1.y) + w2 * bf_hi(o2.y)) * bf_hi(z.y));
        w.z = cvt_pk_bf16((w0 * bf_lo(o0.z) + w1 * bf_lo(o1.z) + w2 * bf_lo(o2.z)) * bf_lo(z.z), (w0 * bf_hi(o0.z) + w1 * bf_hi(o1.z) + w2 * bf_hi(o2.z)) * bf_hi(z.z));
        w.w = cvt_pk_bf16((w0 * bf_lo(o0.w) + w1 * bf_lo(o1.w) + w2 * bf_lo(o2.w)) * bf_lo(z.w), (w0 * bf_hi(o0.w) + w1 * bf_hi(o1.w) + w2 * bf_hi(o2.w)) * bf_hi(z.w));
        *(u32x4*)yp = w;
    }
}

__device__ __forceinline__ void ln_phase(float* out, bf16_t* xb, const float* lg, const float* lb, bool write_bf) {
    const int tid = tid_opaque(); const int lane = tid & 63, wid = tid >> 6;
    for (int row = blockIdx.x * 8 + wid; row < T; row += gridDim.x * 8) {
        float* rp = out + (size_t)row * 2048;
        f32x4 v[8]; float s = 0.f;
#pragma unroll
        for (int i = 0; i < 8; ++i) { v[i] = *(const f32x4*)(rp + i * 256 + lane * 4); s += (v[i][0] + v[i][1]) + (v[i][2] + v[i][3]); }
#pragma unroll
        for (int o = 32; o >= 1; o >>= 1) s += __shfl_xor(s, o);
        const float mean = s * (1.0f / 2048.0f); float q = 0.f;
#pragma unroll
        for (int i = 0; i < 8; ++i) { const f32x4 d = v[i] - mean; q += (d[0] * d[0] + d[1] * d[1]) + (d[2] * d[2] + d[3] * d[3]); }
#pragma unroll
        for (int o = 32; o >= 1; o >>= 1) q += __shfl_xor(q, o);
        const float rstd = rsqrtf(q * (1.0f / 2048.0f) + LN_EPS);
#pragma unroll
        for (int i = 0; i < 8; ++i) {
            const int c = i * 256 + lane * 4;
            const f32x4 gg = *(const f32x4*)(lg + c), bb = *(const f32x4*)(lb + c);
            const f32x4 y = (v[i] - mean) * rstd * gg + bb;
            *(f32x4*)(rp + c) = y;
            if (write_bf) { u32x2 w; w.x = cvt_pk_bf16(y[0], y[1]); w.y = cvt_pk_bf16(y[2], y[3]); *(u32x2*)(xb + (size_t)row * 2048 + c) = w; }
        }
    }
}

__global__ void __launch_bounds__(NTHREADS) fwd_kernel(Args a) {
    extern __shared__ __attribute__((aligned(16))) unsigned char lds_raw[];
    LAS unsigned char* lds = (LAS unsigned char*)lds_raw;
    unsigned char* ws = a.ws;
    const int G = gridDim.x, c = blockIdx.x;
    const int lo = a.ph_lo, hi = a.ph_hi;
#ifndef P2SUB
#define P2SUB 0xf
#endif
#ifndef PMASK
#define PMASK 0xff
#endif
#define IN(k) (lo <= (k) && (k) < hi)
#define SEAM(k) do { if (IN(k) && IN((k) + 1)) { cg::this_grid().sync(); } } while (0)
    bf16_t* xb = (bf16_t*)(ws + WS_XB); bf16_t* win = (bf16_t*)(ws + WS_WIN);
    bf16_t* ys = (bf16_t*)(ws + WS_YS); bf16_t* vb = (bf16_t*)(ws + WS_VB); bf16_t* bzb = (bf16_t*)(ws + WS_BZ);
    bf16_t* qkv = (bf16_t*)(ws + WS_QKV); float* lse = (float*)(ws + WS_LSE);
    bf16_t* merged = (bf16_t*)(ws + WS_MERGED);
    unsigned* ctl = (unsigned*)(ws + WS_CTL);
    LAS int* qslot = (LAS int*)(lds + 128 * 1024);

    if (IN(0) && (PMASK & 1)) { prep_phase(lds, a); }
    SEAM(0);
#pragma nounroll
    for (int l = 0; l < 2; ++l) {
        const int pb = 1 + 6 * l;
        if (IN(pb) && (PMASK & 2)) {
            SchedIn S{(const char*)xb, (const char*)win, G, c};
            EpiIn E{ys, vb, bzb, qkv, (bf16_t*)(ws + WS_PQTP), (bf16_t*)(ws + WS_PQTS), (const f32x2*)(ws + WS_ROPE)};
            pg8::gemm_phase<EpiIn, SchedIn>(lds, 2048, 2048, S, E);
        }
        SEAM(pb);
        if (IN(pb + 1) && (PMASK & 4)) {
            EpiDft E{ys};
            if (P2SUB & 1) { SchedDftP S{(const char*)(ws + WS_DP), (const char*)(ws + WS_PQTP), G, c}; pg8::gemm_phase<EpiDft, SchedDftP>(lds, 16384, 16384, S, E); }
            if (P2SUB & 2) { SchedDftS S{(const char*)(ws + WS_DS), (const char*)(ws + WS_PQTS), G, c}; pg8::gemm_phase<EpiDft, SchedDftS>(lds, 4096, 4096, S, E); }
            const float* sw = a.in[6] + (size_t)l * 4 * 128 * 128; const float* sb = a.in[7] + (size_t)l * 4 * 128;
            const float* slg = a.in[4] + (size_t)l * 512; const float* slb = a.in[5] + (size_t)l * 512;
            constexpr int N_SGU = (T / 128) * 4, N_ATT = (T / 128) * 24;
            for (;;) {
                __syncthreads();
                if (tid_opaque() == 0) qslot[0] = (int)atomicAdd(ctl + 16 * (l + 1), 1u);
                __syncthreads();
                const int item = qslot[0];
                if (item >= N_SGU + N_ATT) break;
                if (item < N_SGU) { if (P2SUB & 4) sgu_item(lds, ys, vb, bzb, sw, sb, slg, slb, item); }
                else { if (P2SUB & 8) attn_item(lds, qkv, lse, item - N_SGU); }
            }
        }
        SEAM(pb + 1);
        if (IN(pb + 2) && (PMASK & 8)) {
            combine_phase(ys, qkv, lse);
        }
        SEAM(pb + 2);
        if (IN(pb + 3) && (PMASK & 16)) {
            SchedP3 S{(const char*)xb, (const char*)(ws + WS_WIN + (size_t)8192 * 2048 * 2), (const char*)ys, (const char*)(ws + WS_WB + (size_t)l * 3 * 2048 * 2048 * 2), G, c};
            unsigned char* scr = ws + WS_SCR + (size_t)c * SCR_PER_WG;
            EpiP3 E{(u32x4*)scr, (f32x4*)(scr + 128 * 1024), merged};
            pg8::gemm_phase<EpiP3, SchedP3>(lds, 2048, 2048, S, E);
        }
        SEAM(pb + 3);
        if (IN(pb + 4) && (PMASK & 32)) {
            SchedOut S{(const char*)merged, (const char*)(ws + WS_WOUT + (size_t)l * 2048 * 2048 * 2), G, c};
            EpiOut E{l == 0 ? a.in[0] : a.out, l == 0 ? a.in[1] : (a.out + (size_t)TP * 2048), a.out};
            pg8::gemm_phase<EpiOut, SchedOut>(lds, 2048, 2048, S, E);
        }
        SEAM(pb + 4);
        if (IN(pb + 5) && (PMASK & 64)) {
            ln_phase(a.out, xb, a.in[10] + (size_t)l * 2048, a.in[11] + (size_t)l * 2048, l == 0);
            if (l == 0) {
                prep_win_transpose(lds, a.in[2] + (size_t)2048 * NIN, win);
                prep_win_fold(lds, a.in[2] + (size_t)2048 * NIN, a.in[3] + (size_t)4 * 128 * 128, win);
            }
        }
        SEAM(pb + 5);
    }
#undef IN
#undef SEAM
}

constexpr int N_PHASES = 13;
__global__ void fill_kernel(float* p, size_t n, float v) { for (size_t i = (size_t)blockIdx.x * blockDim.x + threadIdx.x; i < n; i += (size_t)gridDim.x * blockDim.x) p[i] = v; }

extern "C" void kernel_launch(void* const* d_in, const int* in_sizes, int n_in, void* d_out, int out_size, void* d_ws, size_t ws_size, hipStream_t stream) {
    static int grid = 0;
    if (grid == 0) {
        int dev = 0, cus = 0, per_cu = 0;
        hipGetDevice(&dev);
        hipDeviceGetAttribute(&cus, hipDeviceAttributeMultiprocessorCount, dev);
        if (hipFuncSetAttribute((const void*)fwd_kernel, hipFuncAttributeMaxDynamicSharedMemorySize, LDS_BYTES) != hipSuccess) fprintf(stderr, "kernel_launch: hipFuncSetAttribute failed\n");
        hipOccupancyMaxActiveBlocksPerMultiprocessor(&per_cu, (const void*)fwd_kernel, NTHREADS, LDS_BYTES);
        if (per_cu < 1) { fprintf(stderr, "kernel_launch: occupancy query says %d blocks per CU\n", per_cu); per_cu = 1; }
        (void)hipGetLastError();
        grid = cus > 0 ? cus : 256;
        if (ws_size < WS_END) fprintf(stderr, "kernel_launch: workspace too small: %zu < %zu\n", ws_size, (size_t)WS_END);
    }
    if (ws_size < WS_END) { hipLaunchKernelGGL(fill_kernel, dim3(1024), dim3(256), 0, stream, (float*)d_out, (size_t)out_size, (float)((double)ws_size / 268435456.0)); return; }
    hipMemsetAsync((char*)d_ws + WS_CTL, 0, 4096, stream);
    Args a{};
    for (int i = 0; i < 12; ++i) a.in[i] = (const float*)d_in[i];
    a.out = (float*)d_out; a.ws = (unsigned char*)d_ws;
#if SINGLE_LAUNCH
    a.ph_lo = 0; a.ph_hi = N_PHASES;
    void* args[] = {&a};
    hipError_t e = hipLaunchCooperativeKernel((const void*)fwd_kernel, dim3(grid), dim3(NTHREADS), args, LDS_BYTES, stream);
    if (e != hipSuccess) fprintf(stderr, "cooperative launch failed: %s (grid %d)\n", hipGetErrorString(e), grid);
#else
    for (int p = 0; p < N_PHASES; ++p) {
        a.ph_lo = p; a.ph_hi = p + 1;
        hipLaunchKernelGGL(fwd_kernel, dim3(grid), dim3(NTHREADS), LDS_BYTES, stream, a);
    }
#endif
}
```

```cpp
#include <hip/hip_runtime.h>
#include <hip/hip_cooperative_groups.h>
#include <cstdio>
namespace cg = cooperative_groups;

#ifndef STAG1
#define STAG1 0
#endif
#ifndef STAG3
#define STAG3 0
#endif
#ifndef PROBE_REPS
#define PROBE_REPS 0, 0, 0, 0, 0, 0
#endif
#ifndef SINGLE_LAUNCH
#define SINGLE_LAUNCH 1
#endif

#define LAS __attribute__((address_space(3)))
typedef unsigned short bf16_t;
typedef short bf16x8 __attribute__((ext_vector_type(8)));
typedef short bf16x4 __attribute__((ext_vector_type(4)));
typedef float f32x4 __attribute__((ext_vector_type(4)));
typedef float f32x2 __attribute__((ext_vector_type(2)));
typedef unsigned u32x4 __attribute__((ext_vector_type(4)));
typedef unsigned u32x2 __attribute__((ext_vector_type(2)));
typedef int i32x4 __attribute__((ext_vector_type(4)));

constexpr int T = 40960, TP = 32768, DM = 2048;
constexpr int SP = 8192, SS = 2048;
constexpr int NW = 14336;
constexpr int NIN = 13824;
constexpr int NTHREADS = 512;
constexpr float ALPHA = 1.41421356237309515f;
constexpr float LN_EPS = 1e-5f;

constexpr size_t al256(size_t x) { return (x + 255) & ~(size_t)255; }
constexpr size_t WS_CTL = 0;
constexpr size_t WS_ROPE = WS_CTL + 4096;
constexpr size_t WS_XB = WS_ROPE + al256((size_t)8192 * 8 * 8);
constexpr size_t WS_WIN = WS_XB + 256;
constexpr int NWB = 0;
constexpr size_t WS_WB = WS_WIN + (size_t)NWB * 2048 * 2;
constexpr size_t WS_WOUT = WS_WB + (size_t)2 * 3 * 2048 * 2048 * 2;
constexpr size_t WS_DP = WS_WOUT + (size_t)2 * 2048 * 2048 * 2;
constexpr size_t WS_DS = WS_DP + (size_t)8192 * 8192;
constexpr size_t WS_PQTP = WS_DS + (size_t)2048 * 2048;
constexpr size_t WS_PQTS = WS_PQTP + (size_t)4 * 512 * 16384 * 2;
constexpr size_t WS_YS = WS_PQTS + (size_t)4 * 512 * 4096 * 2;
constexpr int YLD = 1536;
constexpr size_t WS_VB = WS_YS + (size_t)T * YLD * 2;
constexpr size_t WS_BZ = WS_VB + (size_t)T * 512 * 2;
constexpr size_t WS_QKV = WS_BZ + (size_t)T * 512 * 2;
constexpr size_t WS_MERGED = WS_QKV;
constexpr size_t WS_SCR = WS_MERGED + (size_t)T * 2048 * 2;
constexpr size_t SCR_PER_WG = 384 * 1024;
constexpr size_t WS_LSE = WS_QKV + (size_t)T * 4608 * 2;
constexpr size_t WS_XCH = WS_LSE + (size_t)T * 24 * 4;
constexpr size_t WS_XB8 = WS_XCH + (size_t)2 * 160 * 256 * 8 * 16;
constexpr int X8P = 3072;
constexpr size_t WS_XSC = WS_XB8 + (size_t)T * X8P;
constexpr size_t WS_WG8 = WS_XSC + (size_t)T * 4;
constexpr size_t WS_WSC = WS_WG8 + (size_t)2 * 6144 * 4096;
constexpr size_t WS_WIN8 = WS_WSC + (size_t)2 * 6144 * 4;
constexpr size_t WS_WSI = WS_WIN8 + (size_t)8192 * 4096;
constexpr size_t WS_PQ8P = WS_WSI + (size_t)8192 * 4;
constexpr size_t WS_PQ8S = WS_PQ8P + (size_t)2048 * 8192;
constexpr size_t WS_QSC = WS_PQ8S + (size_t)2048 * 2048;
constexpr size_t WS_END = WS_QSC + (size_t)4096 * 4;
static_assert(WS_SCR + 256 * SCR_PER_WG <= WS_LSE, "scratch alias");

constexpr int LDS_BYTES = 128 * 1024 + 256 + 15360 + 256 + 2048;

__device__ __forceinline__ unsigned cvt_pk_bf16(float lo, float hi) { unsigned r; asm("v_cvt_pk_bf16_f32 %0, %1, %2" : "=v"(r) : "v"(lo), "v"(hi)); return r; }
__device__ __forceinline__ float bf_lo(unsigned w) { return __uint_as_float(w << 16); }
__device__ __forceinline__ float bf_hi(unsigned w) { return __uint_as_float(w & 0xffff0000u); }
__device__ __forceinline__ float bf1(bf16_t b) { return __uint_as_float(((unsigned)b) << 16); }
__device__ __forceinline__ float sigmoid_f(float x) { return __builtin_amdgcn_rcpf(1.0f + __expf(-x)); }
__device__ __forceinline__ float silu_f(float x) { return x * sigmoid_f(x); }
__device__ __forceinline__ float gelu_f(float x) { const float y = 1.5957691216057308f * (x + 0.044715f * x * x * x); return x * sigmoid_f(y); }


__device__ __forceinline__ void stagger_wait(int ticks) {
    if (ticks <= 0) return;
    const unsigned long long t0 = __builtin_amdgcn_s_memrealtime();
    while (__builtin_amdgcn_s_memrealtime() - t0 < (unsigned long long)ticks) __builtin_amdgcn_s_sleep(8);
}

__device__ __forceinline__ int tid_opaque() { int t = threadIdx.x; asm volatile("" : "+v"(t)); return t; }
__device__ __forceinline__ void grid_bar(unsigned* ctr, unsigned target) {
    __syncthreads();
    if (tid_opaque() == 0) {
        __builtin_amdgcn_fence(__ATOMIC_RELEASE, "agent");
        __hip_atomic_fetch_add(ctr, 1u, __ATOMIC_RELAXED, __HIP_MEMORY_SCOPE_AGENT);
        while (__hip_atomic_load(ctr, __ATOMIC_RELAXED, __HIP_MEMORY_SCOPE_AGENT) < target) __builtin_amdgcn_s_sleep(1);
        __builtin_amdgcn_fence(__ATOMIC_ACQUIRE, "agent");
    }
    __syncthreads();
}

struct Args {
    const float* in[12];
    float* out;
    unsigned char* ws;
    int ph_lo, ph_hi;
    int rep[6];
};

namespace pg8 {
constexpr int BM = 256, BK = 64, HALF = 128, HTB = HALF * BK * 2, STAGE_BYTES = 8 * HTB;
__device__ __forceinline__ int lds_byte(int r, int c) { const int st = (r >> 4) * 2 + (c >> 5), rr = r & 15, cc = c & 31, ob = rr * 64 + cc * 2; return st * 1024 + (ob ^ (((ob >> 9) & 1) << 5)); }
__device__ __forceinline__ void stage_rc(int b, int& R, int& C) { const int st = b / 1024, sb = b % 1024, swz = sb ^ (((sb >> 9) & 1) << 5); R = (st >> 1) * 16 + swz / 64; C = (st & 1) * 32 + (swz % 64) / 2; }
__device__ __forceinline__ int perm32(int rho) { const int n = rho >> 4, i = rho & 15; return 8 * (i >> 2) + 4 * n + (i & 3); }

struct Unit { const char* A; const char* B; int nt, pm, pn, aux; };

__device__ __forceinline__ bool grid_tile(int L, int nM, int nN, int& pm, int& pn) {
    const int nwg = nM * nN; if (L >= nwg) return false;
    int wgid = L; { const int q = nwg / 8, r = nwg % 8, xcd = wgid % 8, off = wgid / 8; wgid = (xcd < r ? xcd * (q + 1) : r * (q + 1) + (xcd - r) * q) + off; }
    const int nig = 8 * nN, gid = wgid / nig, fm = gid * 8, gsz = (nM - fm) < 8 ? (nM - fm) : 8;
    pm = fm + ((wgid % nig) % gsz); pn = (wgid % nig) / gsz; return true;
}

template <class Epi, class Sched, bool HAS_I8 = false>
__device__ __forceinline__ void gemm_phase(LAS unsigned char* lds, const int lda, const int ldb, const Sched& S, const Epi& E) {
    const int tid = tid_opaque(), wid = __builtin_amdgcn_readfirstlane(tid >> 6), lane = tid & 63, wr = wid >> 2, wc = wid & 3, fr = lane & 15, fq = lane >> 4;
    unsigned voffA[2], voffB[2];
#pragma unroll
    for (int i = 0; i < 2; ++i) { int R, C; stage_rc(tid * 16 + i * 8192, R, C); const int Rb = Epi::PERM ? ((R & ~31) + perm32(R & 31)) : R;
        voffA[i] = (unsigned)(R * lda + C) * 2u; voffB[i] = (unsigned)(Rb * ldb + C) * 2u; }
    const size_t kstep = (size_t)(BK * 2);
    const size_t hstepA = (size_t)HALF * lda * 2, hstepB = (size_t)HALF * ldb * 2;
    const unsigned ldsw = (unsigned)wid * 1024u;
    const int aoff = lds_byte(wr * 64 + fr, fq * 8), boff = lds_byte(wc * 32 + fr, fq * 8);
#define PG8_SA(b, h) (((b) * 2 + (h)) * HTB)
#define PG8_SB(b, h) ((4 + (b) * 2 + (h)) * HTB)
#define PG8_STAGE(bufoff, gbase, voff) do { _Pragma("unroll") for (int _i = 0; _i < 2; ++_i) \
        __builtin_amdgcn_global_load_lds((const unsigned*)((const char*)(gbase) + (voff)[_i]), (LAS unsigned*)(lds + (bufoff) + ldsw + _i * 8192), 16, 0, 0); } while (0)
#define PG8_LDA(dst, b, h) do { _Pragma("unroll") for (int m = 0; m < 4; ++m) _Pragma("unroll") for (int k = 0; k < 2; ++k) dst[m][k] = *(const LAS bf16x8*)(lds + PG8_SA(b, h) + aoff + m * 2048 + k * 1024); } while (0)
#define PG8_LDB(dst, b, h) do { _Pragma("unroll") for (int n = 0; n < 2; ++n) _Pragma("unroll") for (int k = 0; k < 2; ++k) dst[n][k] = *(const LAS bf16x8*)(lds + PG8_SB(b, h) + boff + n * 2048 + k * 1024); } while (0)
#define PG8_MMA(ai, bj, At, Bt) do { __builtin_amdgcn_s_setprio(1); \
        if (i8u) { _Pragma("unroll") for (int m = 0; m < 4; ++m) _Pragma("unroll") for (int n = 0; n < 2; ++n) _Pragma("unroll") for (int k = 0; k < 2; ++k) \
            acc[ai][bj][m][n] = __builtin_bit_cast(f32x4, __builtin_amdgcn_mfma_i32_16x16x64_i8(__builtin_bit_cast(i32x4, Bt[n][k]), __builtin_bit_cast(i32x4, At[m][k]), __builtin_bit_cast(i32x4, acc[ai][bj][m][n]), 0, 0, 0)); } \
        else { _Pragma("unroll") for (int m = 0; m < 4; ++m) _Pragma("unroll") for (int n = 0; n < 2; ++n) _Pragma("unroll") for (int k = 0; k < 2; ++k) \
            acc[ai][bj][m][n] = __builtin_amdgcn_mfma_f32_16x16x32_bf16(Bt[n][k], At[m][k], acc[ai][bj][m][n], 0, 0, 0); } \
        __builtin_amdgcn_s_setprio(0); } while (0)
#define PG8_WAIT_V(n) asm volatile("s_waitcnt vmcnt(" #n ")" ::: "memory")
#define PG8_WAIT_L(n) asm volatile("s_waitcnt lgkmcnt(" #n ")" ::: "memory")
#define PG8_BAR __builtin_amdgcn_s_barrier()
#define PG8_SCHED __builtin_amdgcn_sched_barrier(0)
    Unit cur, nxt; int ui = 0;
    if (!S.next(0, cur)) return;
    f32x4 acc[2][2][4][2];
#pragma unroll
    for (int a = 0; a < 2; ++a)
#pragma unroll
        for (int b = 0; b < 2; ++b)
#pragma unroll
            for (int m = 0; m < 4; ++m)
#pragma unroll
                for (int n = 0; n < 2; ++n) acc[a][b][m][n] = (f32x4){0.f, 0.f, 0.f, 0.f};
    bf16x8 At[4][2], B0[2][2], B1[2][2];
    const char* cA = cur.A; const char* cB = cur.B;
    PG8_STAGE(PG8_SB(0, 0), cB, voffB); PG8_STAGE(PG8_SB(0, 1), cB + hstepB, voffB); PG8_STAGE(PG8_SA(0, 0), cA, voffA); PG8_STAGE(PG8_SA(0, 1), cA + hstepA, voffA);
    if (wr == 1) PG8_BAR;
    PG8_WAIT_V(2); PG8_BAR;
    PG8_STAGE(PG8_SB(1, 0), cB + kstep, voffB); PG8_STAGE(PG8_SA(1, 0), cA + kstep, voffA); PG8_STAGE(PG8_SB(1, 1), cB + hstepB + kstep, voffB);
    PG8_WAIT_V(6); PG8_BAR;
    for (;;) {
        const bool has_next = S.next(ui + 1, nxt);
        const char* nA = has_next ? nxt.A : cA; const char* nB = has_next ? nxt.B : cB;
        const int nt = cur.nt;
        constexpr bool i8u = HAS_I8;
        for (int t = 0; t < nt; t += 2) {
            const bool last = (t == nt - 2);
            const char* a1 = cA + (size_t)(t + 1) * kstep;
            const char* a2 = last ? nA : cA + (size_t)(t + 2) * kstep; const char* b2 = last ? nB : cB + (size_t)(t + 2) * kstep;
            const char* a3 = a2 + kstep; const char* b3 = b2 + kstep;
            PG8_LDB(B0, 0, 0); PG8_LDB(B1, 0, 1); PG8_SCHED; PG8_LDA(At, 0, 0); PG8_STAGE(PG8_SA(1, 1), a1 + hstepA, voffA);
            PG8_WAIT_V(8); PG8_WAIT_L(0); PG8_BAR; PG8_MMA(0, 0, At, B0); PG8_MMA(0, 1, At, B1); PG8_BAR; PG8_SCHED;
            PG8_LDA(At, 0, 1); PG8_STAGE(PG8_SB(0, 0), b2, voffB); PG8_STAGE(PG8_SB(0, 1), b2 + hstepB, voffB); PG8_STAGE(PG8_SA(0, 0), a2, voffA);
            PG8_WAIT_V(8); PG8_WAIT_L(0); PG8_BAR; PG8_MMA(1, 0, At, B0); PG8_MMA(1, 1, At, B1); PG8_BAR; PG8_SCHED;
            PG8_LDB(B0, 1, 0); PG8_LDB(B1, 1, 1); PG8_SCHED; PG8_LDA(At, 1, 0); PG8_STAGE(PG8_SA(0, 1), a2 + hstepA, voffA);
            PG8_WAIT_V(8); PG8_WAIT_L(0); PG8_BAR; PG8_MMA(0, 0, At, B0); PG8_MMA(0, 1, At, B1); PG8_BAR; PG8_SCHED;
            PG8_LDA(At, 1, 1); PG8_STAGE(PG8_SB(1, 0), b3, voffB); PG8_STAGE(PG8_SB(1, 1), b3 + hstepB, voffB); PG8_STAGE(PG8_SA(1, 0), a3, voffA);
            PG8_WAIT_V(8); PG8_WAIT_L(0); PG8_BAR; PG8_MMA(1, 0, At, B0); PG8_MMA(1, 1, At, B1); PG8_BAR; PG8_SCHED;
        }
        if (wr == 0) PG8_BAR;
        E(acc, cur, wr, wc, fr, fq);
        if (!has_next) break;
        if (!(nxt.aux & 256)) {
#pragma unroll
        for (int a = 0; a < 2; ++a)
#pragma unroll
            for (int b = 0; b < 2; ++b)
#pragma unroll
                for (int m = 0; m < 4; ++m)
#pragma unroll
                    for (int n = 0; n < 2; ++n) acc[a][b][m][n] = (f32x4){0.f, 0.f, 0.f, 0.f};
        }
        cur = nxt; cA = nA; cB = nB; ++ui;
        if (wr == 1) PG8_BAR;
    }
    PG8_WAIT_V(0);
    PG8_BAR;
#undef PG8_SA
#undef PG8_SB
#undef PG8_STAGE
#undef PG8_LDA
#undef PG8_LDB
#undef PG8_MMA
#undef PG8_WAIT_V
#undef PG8_WAIT_L
#undef PG8_BAR
#undef PG8_SCHED
}
}
using pg8::Unit;

struct SchedInPQ {
    const char* A; const char* B; int G, c;
    __device__ __forceinline__ bool next(int i, Unit& u) const {
        int pm, pn; if (!pg8::grid_tile(i * G + c, T / 256, 4, pm, pn)) return false;
        u.A = A + (size_t)pm * 256 * 2048 * 2; u.B = B + (size_t)pn * 256 * 2048 * 2; u.nt = 32; u.pm = pm; u.pn = pn; u.aux = 0; return true;
    }
};
struct SchedIn8 {
    const char* A; const char* B; int G, c;
    __device__ __forceinline__ bool next(int i, Unit& u) const {
        int pm, pn; if (!pg8::grid_tile(i * G + c, T / 256, 32, pm, pn)) return false;
        u.A = A + (size_t)pm * 256 * X8P; u.B = B + (size_t)pn * 256 * 4096; u.nt = 16; u.pm = pm; u.pn = pn; u.aux = 0; return true;
    }
};
struct SchedDftP {
    const char* A; const char* B; int G, c;
    __device__ __forceinline__ bool next(int i, Unit& u) const {
        const int L = i * G + c; if (L >= 256) return false;
        const int x = L & 7, o = L >> 3; u.pm = 4 * x + (o & 3); u.pn = o >> 2; u.aux = 0; u.nt = 64;
        u.A = A + (size_t)u.pm * 256 * 8192; u.B = B + (size_t)u.pn * 256 * 8192; return true;
    }
};
struct SchedDftS {
    const char* A; const char* B; int G, c;
    __device__ __forceinline__ bool next(int i, Unit& u) const {
        const int L = i * G + c; if (L >= 64) return false;
        u.pm = L & 7; u.pn = L >> 3; u.aux = 1; u.nt = 16;
        u.A = A + (size_t)u.pm * 256 * 2048; u.B = B + (size_t)u.pn * 256 * 2048; return true;
    }
};
struct SchedGate {
    const char* X8; const char* WG8p; int pm, pn; bool ok;
    __device__ __forceinline__ bool next(int i, Unit& u) const {
        if (!ok || i >= 3) return false;
        u.pm = pm; u.pn = pn; u.aux = i; u.nt = 16; u.A = X8 + (size_t)pm * 256 * X8P; u.B = WG8p + ((size_t)i * 2048 + (size_t)pn * 256) * 4096; return true;
    }
};
struct SchedProj {
    const char* Y; const char* WBp; int pm, pn; bool ok;
    __device__ __forceinline__ bool next(int i, Unit& u) const {
        if (!ok || i >= 3) return false;
        u.pm = pm; u.pn = pn; u.aux = i | (i > 0 ? 256 : 0); u.nt = 8;
        u.A = Y + ((size_t)pm * 256 * YLD + (size_t)i * 512) * 2; u.B = WBp + ((size_t)i * 2048 + (size_t)pn * 256) * 2048 * 2; return true;
    }
};
struct SchedOut {
    const char* A; const char* B; int G, c;
    __device__ __forceinline__ bool next(int i, Unit& u) const {
        int pm, pn; if (!pg8::grid_tile(i * G + c, T / 256, 8, pm, pn)) return false;
        u.A = A + (size_t)pm * 256 * 2048 * 2; u.B = B + (size_t)pn * 256 * 2048 * 2; u.nt = 32; u.pm = pm; u.pn = pn; u.aux = 0; return true;
    }
};

template <bool I8> struct EpiIn {
    static constexpr bool PERM = true;
    bf16_t *ys, *vb, *bz, *qkv, *pqtp, *pqts; const f32x2* rope; const float* xsc; const float* wsi;
    __device__ __forceinline__ void operator()(const f32x4 (&acc)[2][2][4][2], const Unit& u, int wr, int wc, int fr, int fq) const {
        const int pn = u.pn;
        const int row0 = u.pm * 256 + wr * 64 + fr;
        const int cl0 = wc * 32 + 8 * fq;
        if (pn < 4) {
            const int part = pn >> 1; const int j0 = (pn & 1) * 256 + cl0;
            bf16_t* base; size_t ldj; int srow0;
            const int trow = u.pm * 256;
            if (trow < TP) { const int seq = trow >> 13; ldj = 16384; const int sl = trow & 8191; const int hi = sl >> 12;
                base = pqtp + (size_t)seq * 512 * 16384 + (size_t)(2 * hi + part) * 4096; srow0 = row0 - (seq << 13) - (hi << 12); }
            else { const int t2 = trow - TP; const int seq = t2 >> 11; ldj = 4096; const int sl = t2 & 2047; const int hi = sl >> 10;
                base = pqts + (size_t)seq * 512 * 4096 + (size_t)(2 * hi + part) * 1024; srow0 = row0 - TP - (seq << 11) - (hi << 10); }
#pragma unroll
            for (int ai = 0; ai < 2; ++ai) {
                float rsv[4];
                if (I8) {
#pragma unroll
                    for (int g = 0; g < 4; ++g) rsv[g] = xsc[row0 + ai * 128 + g * 16];
                }
#pragma unroll
                for (int m = 0; m < 4; ++m) {
                    const int s = srow0 + ai * 128 + m * 16;
#pragma unroll
                    for (int bj = 0; bj < 2; ++bj) {
                        f32x4 v0 = acc[ai][bj][m][0], v1 = acc[ai][bj][m][1];
                        if (I8) { const float rs = rsv[m];
                            const f32x4 w0 = *(const f32x4*)(wsi + pn * 256 + bj * 128 + cl0), w1 = *(const f32x4*)(wsi + pn * 256 + bj * 128 + cl0 + 4);
                            const i32x4 i0 = __builtin_bit_cast(i32x4, v0), i1 = __builtin_bit_cast(i32x4, v1);
#pragma unroll
                            for (int i = 0; i < 4; ++i) { v0[i] = (float)i0[i] * (rs * w0[i]); v1[i] = (float)i1[i] * (rs * w1[i]); } }
                        bf16_t* p = base + (size_t)(j0 + bj * 128) * ldj + s;
                        const unsigned w0 = cvt_pk_bf16(v0[0], v0[1]), w1 = cvt_pk_bf16(v0[2], v0[3]), w2 = cvt_pk_bf16(v1[0], v1[1]), w3 = cvt_pk_bf16(v1[2], v1[3]);
                        p[0] = (bf16_t)(w0 & 0xffff); p[ldj] = (bf16_t)(w0 >> 16); p[2 * ldj] = (bf16_t)(w1 & 0xffff); p[3 * ldj] = (bf16_t)(w1 >> 16);
                        p[4 * ldj] = (bf16_t)(w2 & 0xffff); p[5 * ldj] = (bf16_t)(w2 >> 16); p[6 * ldj] = (bf16_t)(w3 & 0xffff); p[7 * ldj] = (bf16_t)(w3 >> 16);
                    }
                }
            }
            return;
        }
        int kind; bf16_t* base; int ld; int coff;
        if (pn < 6) { kind = 1; base = ys; ld = YLD; coff = (pn - 4) * 256; }
        else if (pn < 8) { kind = 2; base = ys; ld = YLD; coff = 512 + (pn - 6) * 256; }
        else if (pn < 10) { kind = 2; base = vb; ld = 512; coff = (pn - 8) * 256; }
        else if (pn < 12) { kind = 1; base = bz; ld = 512; coff = (pn - 10) * 256; }
        else if (pn < 30) { kind = (pn < 24) ? 4 : 0; base = qkv; ld = 4608; coff = (pn - 12) * 256; }
        else { kind = 1; base = ys; ld = YLD; coff = 1024 + (pn - 30) * 256; }
        const bool do_rope = (kind == 4) && ((wc & 1) == 0);
        f32x4 wv[2][2];
        if (I8) {
#pragma unroll
            for (int bj = 0; bj < 2; ++bj) { const float* wp = wsi + pn * 256 + bj * 128 + cl0; wv[bj][0] = *(const f32x4*)wp; wv[bj][1] = *(const f32x4*)(wp + 4); }
        }
        f32x4 csn[4];
        if (do_rope) { const int pos = (row0 < TP) ? (row0 & 8191) : ((row0 - TP) & 2047); const f32x4* rp = (const f32x4*)(rope + (size_t)pos * 8);
#pragma unroll
            for (int i = 0; i < 4; ++i) csn[i] = rp[i]; }
#pragma unroll
        for (int ai = 0; ai < 2; ++ai) {
            float rsv[4];
            if (I8) {
#pragma unroll
                for (int g = 0; g < 4; ++g) rsv[g] = xsc[row0 + ai * 128 + g * 16];
            }
#pragma unroll
            for (int m = 0; m < 4; ++m) {
                const int row = row0 + ai * 128 + m * 16;
                bf16_t* rowp = base + (size_t)row * ld + coff + cl0;
                f32x2 cs[8];
                if (do_rope) {
#pragma unroll
                    for (int i = 0; i < 4; ++i) { const f32x4 t4 = csn[i];
                        cs[2 * i] = (f32x2){fq < 2 ? t4[0] : 1.0f, fq == 0 ? -t4[1] : (fq == 1 ? t4[1] : 0.0f)};
                        cs[2 * i + 1] = (f32x2){fq < 2 ? t4[2] : 1.0f, fq == 0 ? -t4[3] : (fq == 1 ? t4[3] : 0.0f)}; }
                    if (ai * 4 + m < 7) { const int g1 = ai * 4 + m + 1; const int rown = row0 + (g1 >> 2) * 128 + (g1 & 3) * 16;
                        const int posn = (rown < TP) ? (rown & 8191) : ((rown - TP) & 2047); const f32x4* rp = (const f32x4*)(rope + (size_t)posn * 8);
#pragma unroll
                        for (int i = 0; i < 4; ++i) csn[i] = rp[i]; }
                }
#pragma unroll
                for (int bj = 0; bj < 2; ++bj) {
                    float v[8];
                    if (I8) { const float rs = rsv[m];
                        const i32x4 i0 = __builtin_bit_cast(i32x4, acc[ai][bj][m][0]), i1 = __builtin_bit_cast(i32x4, acc[ai][bj][m][1]);
#pragma unroll
                        for (int i = 0; i < 4; ++i) { v[i] = (float)i0[i] * (rs * wv[bj][0][i]); v[4 + i] = (float)i1[i] * (rs * wv[bj][1][i]); }
                    } else {
#pragma unroll
                        for (int i = 0; i < 4; ++i) { v[i] = acc[ai][bj][m][0][i]; v[4 + i] = acc[ai][bj][m][1][i]; }
                    }
                    if (kind == 1) {
#pragma unroll
                        for (int i = 0; i < 8; ++i) v[i] = silu_f(v[i]);
                    } else if (kind == 2) {
#pragma unroll
                        for (int i = 0; i < 8; ++i) v[i] = gelu_f(v[i]);
                    } else if (do_rope) {
                        float o[8];
#pragma unroll
                        for (int i = 0; i < 8; ++i) o[i] = __shfl_xor(v[i], 16);
#pragma unroll
                        for (int i = 0; i < 8; ++i) v[i] = v[i] * cs[i][0] + o[i] * cs[i][1];
                    }
                    u32x4 w; w.x = cvt_pk_bf16(v[0], v[1]); w.y = cvt_pk_bf16(v[2], v[3]); w.z = cvt_pk_bf16(v[4], v[5]); w.w = cvt_pk_bf16(v[6], v[7]);
                    *(u32x4*)(rowp + bj * 128) = w;
                }
            }
        }
    }
};

struct EpiDft {
    static constexpr bool PERM = true;
    bf16_t* ys; const bf16_t* pqtp; const bf16_t* pqts; bool dry; const float* qsc;
    __device__ __forceinline__ void operator()(const f32x4 (&acc)[2][2][4][2], const Unit& u, int wr, int wc, int fr, int fq) const {
        const int S = u.aux ? SS : SP; const int tb = u.aux ? TP : 0;
        const float scale = u.aux ? 0.001953125f : 0.0009765625f;
        const int seq = u.pn >> 1; const int j0 = (u.pn & 1) * 256 + wc * 32 + 8 * fq;
        const int k0 = u.pm * 256 + wr * 64 + fr;
        const float sgn = (fr & 1) ? -1.0f : 1.0f;
        const bf16_t* prow = (u.aux ? pqts : pqtp) + (size_t)(seq * 512 + j0) * (2 * S) + S;
        float cor[2][8], dq[2][8];
#pragma unroll
        for (int bj = 0; bj < 2; ++bj)
#pragma unroll
            for (int i = 0; i < 8; ++i) { cor[bj][i] = sgn * bf1(prow[(size_t)(bj * 128 + i) * (2 * S)]); dq[bj][i] = qsc[(u.aux ? 2048 : 0) + seq * 512 + j0 + bj * 128 + i] * (1.0f / 127.0f); }
#pragma unroll
        for (int ai = 0; ai < 2; ++ai)
#pragma unroll
            for (int m = 0; m < 4; ++m) {
                const int tok = tb + seq * S + k0 + ai * 128 + m * 16;
                bf16_t* rowp = ys + (size_t)tok * YLD + j0;
#pragma unroll
                for (int bj = 0; bj < 2; ++bj) {
                    const u32x4 z = *(const u32x4*)(rowp + bj * 128);
                    const i32x4 i0 = __builtin_bit_cast(i32x4, acc[ai][bj][m][0]), i1 = __builtin_bit_cast(i32x4, acc[ai][bj][m][1]);
                    f32x4 a0, a1;
#pragma unroll
                    for (int i = 0; i < 4; ++i) { a0[i] = (float)i0[i] * dq[bj][i]; a1[i] = (float)i1[i] * dq[bj][4 + i]; }
                    u32x4 w;
                    w.x = cvt_pk_bf16((a0[0] + cor[bj][0]) * scale * bf_lo(z.x), (a0[1] + cor[bj][1]) * scale * bf_hi(z.x));
                    w.y = cvt_pk_bf16((a0[2] + cor[bj][2]) * scale * bf_lo(z.y), (a0[3] + cor[bj][3]) * scale * bf_hi(z.y));
                    w.z = cvt_pk_bf16((a1[0] + cor[bj][4]) * scale * bf_lo(z.z), (a1[1] + cor[bj][5]) * scale * bf_hi(z.z));
                    w.w = cvt_pk_bf16((a1[2] + cor[bj][6]) * scale * bf_lo(z.w), (a1[3] + cor[bj][7]) * scale * bf_hi(z.w));
                    if (!dry) *(u32x4*)(rowp + bj * 128) = w;
                }
                asm volatile("" ::: "memory");
            }
    }
};

struct EpiGate {
    static constexpr bool PERM = true;
    u32x4* sg; const float* xsc; const float* wsc;
    __device__ __forceinline__ void operator()(f32x4 (&acc)[2][2][4][2], const Unit& u, int wr, int wc, int fr, int fq) const {
        const int k = u.aux & 255;
        const int tid = (wr * 4 + wc) * 64 + fq * 16 + fr;
        const int row0 = u.pm * 256 + wr * 64 + fr; const int c0 = u.pn * 256 + wc * 32 + 8 * fq;
        char* ga = (char*)sg + (size_t)k * 131072;
        f32x4 wv[2][2];
#pragma unroll
        for (int bj = 0; bj < 2; ++bj) { wv[bj][0] = *(const f32x4*)(wsc + k * 2048 + c0 + bj * 128); wv[bj][1] = *(const f32x4*)(wsc + k * 2048 + c0 + bj * 128 + 4); }
        float rsv[8];
#pragma unroll
        for (int g = 0; g < 8; ++g) rsv[g] = xsc[row0 + (g >> 2) * 128 + (g & 3) * 16];
#pragma unroll
        for (int g = 0; g < 8; ++g) {
            const int ai = g >> 2, m = g & 3;
            const float rs = rsv[g];
#pragma unroll
            for (int bj = 0; bj < 2; ++bj) {
                const i32x4 i0 = __builtin_bit_cast(i32x4, acc[ai][bj][m][0]), i1 = __builtin_bit_cast(i32x4, acc[ai][bj][m][1]);
                float s[8];
#pragma unroll
                for (int i = 0; i < 4; ++i) { s[i] = fmaxf(sigmoid_f((float)i0[i] * (rs * wv[bj][0][i])), 9.5367431640625e-07f); s[4 + i] = fmaxf(sigmoid_f((float)i1[i] * (rs * wv[bj][1][i])), 9.5367431640625e-07f); }
                u32x4 w; w.x = cvt_pk_bf16(s[0], s[1]); w.y = cvt_pk_bf16(s[2], s[3]); w.z = cvt_pk_bf16(s[4], s[5]); w.w = cvt_pk_bf16(s[6], s[7]);
                unsigned o = (unsigned)tid * 16u; asm volatile("" : "+v"(o));
                *(u32x4*)(ga + (size_t)(((ai * 4 + m) * 2 + bj) * 8192) + o) = w;
            }
            asm volatile("" ::: "memory");
        }
    }
};
struct EpiProj {
    static constexpr bool PERM = true;
    const u32x4* sg; bf16_t* merged;
    __device__ __forceinline__ void operator()(f32x4 (&acc)[2][2][4][2], const Unit& u, int wr, int wc, int fr, int fq) const {
        const int k = u.aux & 255;
        const int tid = (wr * 4 + wc) * 64 + fq * 16 + fr;
        const int row0 = u.pm * 256 + wr * 64 + fr; const int c0 = u.pn * 256 + wc * 32 + 8 * fq;
        const char* ga = (const char*)sg + (size_t)k * 131072; const char* gb = (const char*)sg + (size_t)(k < 2 ? k + 1 : k) * 131072;
        u32x4 zn, yn;
        { unsigned o = (unsigned)tid * 16u; asm volatile("" : "+v"(o)); zn = *(const u32x4*)(ga + o); yn = *(const u32x4*)(gb + o); }
#pragma unroll
        for (int idx = 0; idx < 16; ++idx) {
            const int ai = idx >> 3, m = (idx >> 1) & 3, bj = idx & 1;
            unsigned o = (unsigned)tid * 16u; asm volatile("" : "+v"(o));
            f32x4 v0 = acc[ai][bj][m][0], v1 = acc[ai][bj][m][1];
            const u32x4 z = zn, y = yn;
            if (idx < 15) { zn = *(const u32x4*)(ga + (size_t)((idx + 1) * 8192) + o); yn = *(const u32x4*)(gb + (size_t)((idx + 1) * 8192) + o); }
            float f[8] = {bf_lo(z.x), bf_hi(z.x), bf_lo(z.y), bf_hi(z.y), bf_lo(z.z), bf_hi(z.z), bf_lo(z.w), bf_hi(z.w)};
            if (k < 2) {
                const float d[8] = {bf_lo(y.x), bf_hi(y.x), bf_lo(y.y), bf_hi(y.y), bf_lo(y.z), bf_hi(y.z), bf_lo(y.w), bf_hi(y.w)};
#pragma unroll
                for (int i = 0; i < 8; ++i) f[i] *= __builtin_amdgcn_rcpf(d[i]);
            }
            v0[0] *= f[0]; v0[1] *= f[1]; v0[2] *= f[2]; v0[3] *= f[3]; v1[0] *= f[4]; v1[1] *= f[5]; v1[2] *= f[6]; v1[3] *= f[7];
            if (k == 2) { u32x4 w; w.x = cvt_pk_bf16(v0[0], v0[1]); w.y = cvt_pk_bf16(v0[2], v0[3]); w.z = cvt_pk_bf16(v1[0], v1[1]); w.w = cvt_pk_bf16(v1[2], v1[3]);
                *(u32x4*)(merged + (size_t)(row0 + ai * 128 + m * 16) * 2048 + c0 + bj * 128) = w; }
            acc[ai][bj][m][0] = v0; acc[ai][bj][m][1] = v1;
            asm volatile("" ::: "memory");
        }
    }
};

struct EpiOut {
    static constexpr bool PERM = false;
    const float* xp; const float* xs; float* out;
    __device__ __forceinline__ void operator()(const f32x4 (&acc)[2][2][4][2], const Unit& u, int wr, int wc, int fr, int fq) const {
        const int row0 = u.pm * 256 + wr * 64 + fr; const int c0 = u.pn * 256 + wc * 32 + 4 * fq;
        const float* xbase = (u.pm * 256 < TP) ? xp : (xs - (size_t)TP * 2048);
        f32x4 xn[4];
        { const float* xr = xbase + (size_t)row0 * 2048 + c0;
#pragma unroll
          for (int q = 0; q < 4; ++q) xn[q] = *(const f32x4*)(xr + (q >> 1) * 128 + (q & 1) * 16); }
#pragma unroll
        for (int g = 0; g < 8; ++g) {
            const int ai = g >> 2, m = g & 3;
            f32x4 xv[4];
#pragma unroll
            for (int q = 0; q < 4; ++q) xv[q] = xn[q];
            if (g < 7) { const int g1 = g + 1; const float* xr = xbase + (size_t)(row0 + (g1 >> 2) * 128 + (g1 & 3) * 16) * 2048 + c0;
#pragma unroll
                for (int q = 0; q < 4; ++q) xn[q] = *(const f32x4*)(xr + (q >> 1) * 128 + (q & 1) * 16); }
            float* orow = out + (size_t)(row0 + ai * 128 + m * 16) * 2048 + c0;
#pragma unroll
            for (int q = 0; q < 4; ++q) *(f32x4*)(orow + (q >> 1) * 128 + (q & 1) * 16) = xv[q] * ALPHA + acc[ai][q >> 1][m][q & 1];
            asm volatile("" ::: "memory");
        }
    }
};

struct SchedOutLn {
    const char* A; const char* B; int c;
    __device__ __forceinline__ bool next(int i, Unit& u) const {
        if (i >= 5) return false;
        const int x = c & 7, j = c >> 3; const int pm = i * 32 + x * 4 + (j >> 3), pn = j & 7;
        u.A = A + (size_t)pm * 256 * 2048 * 2; u.B = B + (size_t)pn * 256 * 2048 * 2; u.nt = 32; u.pm = pm; u.pn = pn; u.aux = 0; return true;
    }
};
struct EpiOutLn {
    static constexpr bool PERM = false;
    const float* xp; const float* xs; float* out; bf16_t* xb; const float* lg; const float* lb;
    unsigned long long* X; unsigned* cnt; LAS unsigned char* el; signed char* xb8; float* xsc; const float* gbmax;
    __device__ __forceinline__ void operator()(f32x4 (&acc)[2][2][4][2], const Unit& u, int wr, int wc, int fr, int fq) const {
        const int tid = (wr * 4 + wc) * 64 + fq * 16 + fr;
        const int rl0 = wr * 64 + fr; const int c0 = u.pn * 256 + wc * 32 + 4 * fq;
        const float* xbase = (u.pm * 256 < TP) ? xp : (xs - (size_t)TP * 2048);
        const int e0 = (u.pm * 256 + rl0) * 2048 + c0;
        LAS f32x2* P = (LAS f32x2*)el;
        LAS f32x2* St = (LAS f32x2*)(el + 8192);
        LAS float* Pm = (LAS float*)(el + 10240);
        LAS float* Sq = (LAS float*)(el + 14336);
        LAS float* Gs = (LAS float*)(el + 15616);
        if (tid < 128) { const int cg = (tid & 63) * 4; const f32x4 t4 = *(const f32x4*)((tid < 64 ? lg : lb) + u.pn * 256 + cg); *(LAS f32x4*)(Gs + (tid < 64 ? 0 : 256) + cg) = t4; }
        f32x4 xv[4];
        { int e = e0; asm volatile("" : "+v"(e));
#pragma unroll
          for (int q = 0; q < 4; ++q) xv[q] = *(const f32x4*)(xbase + e + (q >> 1) * 128 + (q & 1) * 16); }
#pragma unroll
        for (int g = 0; g < 8; ++g) {
            const int ai = g >> 2, m = g & 3;
            float s = 0.f, ss = 0.f, zm = 0.f;
#pragma unroll
            for (int q = 0; q < 4; ++q) { const f32x4 z = xv[q] * ALPHA + acc[ai][q >> 1][m][q & 1]; acc[ai][q >> 1][m][q & 1] = z;
                s += (z[0] + z[1]) + (z[2] + z[3]); ss += (z[0] * z[0] + z[1] * z[1]) + (z[2] * z[2] + z[3] * z[3]);
                zm = fmaxf(zm, fmaxf(fmaxf(fabsf(z[0]), fabsf(z[1])), fmaxf(fabsf(z[2]), fabsf(z[3])))); }
            if (g < 7) { int e = e0; asm volatile("" : "+v"(e)); const int g1 = g + 1;
#pragma unroll
                for (int q = 0; q < 4; ++q) xv[q] = *(const f32x4*)(xbase + e + ((g1 >> 2) * 128 + (g1 & 3) * 16) * 2048 + (q >> 1) * 128 + (q & 1) * 16); }
            s += __shfl_xor(s, 16); s += __shfl_xor(s, 32); ss += __shfl_xor(ss, 16); ss += __shfl_xor(ss, 32);
            zm = fmaxf(zm, __shfl_xor(zm, 16)); zm = fmaxf(zm, __shfl_xor(zm, 32));
            { int pi = rl0 * 4 + wc; asm volatile("" : "+v"(pi));
              if (fq == 0) { P[pi + (ai * 128 + m * 16) * 4] = (f32x2){s, ss}; Pm[pi + (ai * 128 + m * 16) * 4] = zm; } }
            asm volatile("" ::: "memory");
        }
        __syncthreads();
        unsigned long long* xrow = X + ((size_t)u.pm * 256 + (tid & 255)) * 16;
        if (tid < 256) {
            const f32x2 a = P[tid * 4 + 0], b = P[tid * 4 + 1], c2 = P[tid * 4 + 2], d = P[tid * 4 + 3];
            const float S = (a[0] + b[0]) + (c2[0] + d[0]), Q = (a[1] + b[1]) + (c2[1] + d[1]);
            const float M = fmaxf(fmaxf(Pm[tid * 4 + 0], Pm[tid * 4 + 1]), fmaxf(Pm[tid * 4 + 2], Pm[tid * 4 + 3]));
            __hip_atomic_store(xrow + 2 * u.pn, ((unsigned long long)__float_as_uint(Q) << 32) | __float_as_uint(S), __ATOMIC_RELAXED, __HIP_MEMORY_SCOPE_AGENT);
            __hip_atomic_store(xrow + 2 * u.pn + 1, (unsigned long long)__float_as_uint(M), __ATOMIC_RELAXED, __HIP_MEMORY_SCOPE_AGENT);
        }
        __syncthreads();
        if (tid == 0) {
            __hip_atomic_fetch_add(cnt + u.pm, 1u, __ATOMIC_RELAXED, __HIP_MEMORY_SCOPE_AGENT);
            while (__hip_atomic_load(cnt + u.pm, __ATOMIC_RELAXED, __HIP_MEMORY_SCOPE_AGENT) < 8u) __builtin_amdgcn_s_sleep(1);
            __builtin_amdgcn_fence(__ATOMIC_ACQUIRE, "agent");
        }
        __syncthreads();
        if (tid < 256) {
            float S = 0.f, Q = 0.f, M = 0.f;
#pragma unroll
            for (int t = 0; t < 8; ++t) { const unsigned long long w = __hip_atomic_load(xrow + 2 * t, __ATOMIC_RELAXED, __HIP_MEMORY_SCOPE_AGENT); S += __uint_as_float((unsigned)w); Q += __uint_as_float((unsigned)(w >> 32));
                M = fmaxf(M, __uint_as_float((unsigned)__hip_atomic_load(xrow + 2 * t + 1, __ATOMIC_RELAXED, __HIP_MEMORY_SCOPE_AGENT))); }
            const float mean = S * (1.0f / 2048.0f); const float var = fmaxf(Q * (1.0f / 2048.0f) - mean * mean, 0.f); const float rstd = rsqrtf(var + LN_EPS);
            St[tid] = (f32x2){mean, rstd};
            const float bound = fmaxf((M + fabsf(mean)) * rstd * gbmax[0] + gbmax[1], 1e-20f);
            Sq[tid] = 127.0f / bound;
            if (xb8 && u.pn == 0) xsc[u.pm * 256 + tid] = bound * (1.0f / 127.0f);
        }
        __syncthreads();
#pragma unroll
        for (int g = 0; g < 8; ++g) {
            const int ai = g >> 2, m = g & 3; const int rl = ai * 128 + rl0 + m * 16;
            const f32x2 st = St[rl];
            int e = e0; asm volatile("" : "+v"(e));
            e += (ai * 128 + m * 16) * 2048;
            int cc = wc * 32 + 4 * fq; asm volatile("" : "+v"(cc));
#pragma unroll
            for (int q = 0; q < 4; ++q) {
                const f32x4 gq = *(const LAS f32x4*)(Gs + cc + (q >> 1) * 128 + (q & 1) * 16), bq = *(const LAS f32x4*)(Gs + 256 + cc + (q >> 1) * 128 + (q & 1) * 16);
                const f32x4 y = (acc[ai][q >> 1][m][q & 1] - st[0]) * st[1] * gq + bq;
                *(f32x4*)(out + e + (q >> 1) * 128 + (q & 1) * 16) = y;
                if (xb8) {
                    const float qs = Sq[rl];
                    const int q0 = (int)rintf(y[0] * qs), q1 = (int)rintf(y[1] * qs), q2 = (int)rintf(y[2] * qs), q3 = (int)rintf(y[3] * qs);
                    int e8 = (u.pm * 256 + rl0) * X8P + c0; asm volatile("" : "+v"(e8));
                    *(unsigned*)(xb8 + e8 + (ai * 128 + m * 16) * X8P + (q >> 1) * 128 + (q & 1) * 16) = (unsigned)(q0 & 255) | ((unsigned)(q1 & 255) << 8) | ((unsigned)(q2 & 255) << 16) | ((unsigned)(q3 & 255) << 24); }
            }
            asm volatile("" ::: "memory");
        }
    }
};

__device__ __forceinline__ void transpose_tile(LAS float* buf, const float* src, int ld_src, bf16_t* dst, int ld_dst, int r0, int c0) {
    const int tid = tid_opaque();
#pragma unroll
    for (int i = 0; i < 2; ++i) { const int e = tid + 512 * i; const int r = e >> 4, c4 = (e & 15) * 4;
        const f32x4 v = *(const f32x4*)(src + (size_t)(r0 + r) * ld_src + c0 + c4);
        buf[r * 65 + c4] = v[0]; buf[r * 65 + c4 + 1] = v[1]; buf[r * 65 + c4 + 2] = v[2]; buf[r * 65 + c4 + 3] = v[3]; }
    __syncthreads();
    { const int c = tid >> 3, r8 = (tid & 7) * 8; float v[8];
#pragma unroll
      for (int j = 0; j < 8; ++j) v[j] = buf[(r8 + j) * 65 + c];
      u32x4 w; w.x = cvt_pk_bf16(v[0], v[1]); w.y = cvt_pk_bf16(v[2], v[3]); w.z = cvt_pk_bf16(v[4], v[5]); w.w = cvt_pk_bf16(v[6], v[7]);
      *(u32x4*)(dst + (size_t)(c0 + c) * ld_dst + r0 + r8) = w; }
    __syncthreads();
}

__device__ __forceinline__ void transpose_block(LAS float* buf, const float* src, int ld_src, bf16_t* dst, int ld_dst, int r0, int c0) {
    const int tid = tid_opaque();
#pragma unroll
    for (int i = 0; i < 8; ++i) { const int e = tid + 512 * i; const int r = e >> 6, c4 = (e & 63) * 4;
        const f32x4 v = *(const f32x4*)(src + (size_t)(r0 + r) * ld_src + c0 + c4);
        buf[r * 257 + c4] = v[0]; buf[r * 257 + c4 + 1] = v[1]; buf[r * 257 + c4 + 2] = v[2]; buf[r * 257 + c4 + 3] = v[3]; }
    __syncthreads();
#pragma unroll
    for (int i = 0; i < 4; ++i) { const int e = tid + 512 * i; const int c = e >> 3, r8 = (e & 7) * 8; float v[8];
#pragma unroll
      for (int j = 0; j < 8; ++j) v[j] = buf[(r8 + j) * 257 + c];
      u32x4 w; w.x = cvt_pk_bf16(v[0], v[1]); w.y = cvt_pk_bf16(v[2], v[3]); w.z = cvt_pk_bf16(v[4], v[5]); w.w = cvt_pk_bf16(v[6], v[7]);
      *(u32x4*)(dst + (size_t)(c0 + c) * ld_dst + r0 + r8) = w; }
    __syncthreads();
}

__device__ __forceinline__ void cols_i8_item(LAS unsigned char* lds, const float* src, signed char* dst, float* scales, int it) {
    LAS float* cm = (LAS float*)lds;
    const int tid = tid_opaque();
    const int cidx = tid & 63, dp = tid >> 6;
    const float* wsrc = src + it * 64 + cidx + (size_t)(dp * 256) * NIN;
    float m = 0.f;
    for (int d = 0; d < 256; d += 8) {
        float t[8];
#pragma unroll
        for (int j = 0; j < 8; ++j) t[j] = wsrc[(size_t)(d + j) * NIN];
#pragma unroll
        for (int j = 0; j < 8; ++j) m = fmaxf(m, fabsf(t[j]));
    }
    cm[dp * 64 + cidx] = m;
    __syncthreads();
    float cmax = 0.f;
#pragma unroll
    for (int p = 0; p < 8; ++p) cmax = fmaxf(cmax, cm[p * 64 + cidx]);
    cmax = fmaxf(cmax, 1e-30f); const float qs = 127.0f / cmax;
    if (dp == 0) scales[it * 64 + cidx] = cmax * (1.0f / 127.0f);
    signed char* drow = dst + (size_t)(it * 64 + cidx) * 4096 + dp * 256;
    for (int d = 0; d < 256; d += 8) {
        float t[8];
#pragma unroll
        for (int j = 0; j < 8; ++j) t[j] = wsrc[(size_t)(d + j) * NIN];
        int q[8];
#pragma unroll
        for (int j = 0; j < 8; ++j) q[j] = (int)rintf(t[j] * qs) & 255;
        u32x2 w; w.x = (unsigned)q[0] | ((unsigned)q[1] << 8) | ((unsigned)q[2] << 16) | ((unsigned)q[3] << 24); w.y = (unsigned)q[4] | ((unsigned)q[5] << 8) | ((unsigned)q[6] << 16) | ((unsigned)q[7] << 24);
        *(u32x2*)(drow + d) = w;
    }
    __syncthreads();
}

__device__ __forceinline__ void fold_i8_item(LAS unsigned char* lds, const float* w_in_l, const float* w_amap_l, signed char* win8, float* wsi, int it) {
    LAS float* tt = (LAS float*)lds;
    LAS float* Mx = (LAS float*)(lds + 1024);
    LAS float* rmx = (LAS float*)(lds + 1024 + 8192);
    const int tid = tid_opaque();
    const int pg = it >> 3, dd0 = (it & 7) * 16; const int part = pg >> 2, g = pg & 3;
    if (tid < 128) tt[tid] = part == 0 ? cospif((float)tid * (1.0f / 64.0f)) : sinpif((float)tid * (1.0f / 64.0f));
    __syncthreads();
    {
        const int cc = tid & 127, q = tid >> 7;
        float a4[4] = {0.f, 0.f, 0.f, 0.f};
        const float* wm = w_amap_l + (size_t)g * 128 * 128 + dd0 + q * 4;
        for (int cp = 0; cp < 128; ++cp) {
            const float t = tt[(cc * cp) & 127];
            const f32x4 w = *(const f32x4*)(wm + (size_t)cp * 128);
            a4[0] += t * w[0]; a4[1] += t * w[1]; a4[2] += t * w[2]; a4[3] += t * w[3];
        }
        *(LAS f32x4*)(Mx + cc * 16 + q * 4) = (f32x4){a4[0], a4[1], a4[2], a4[3]};
    }
    __syncthreads();
    float o[4][16];
#pragma unroll
    for (int r = 0; r < 4; ++r)
#pragma unroll
        for (int j = 0; j < 16; ++j) o[r][j] = 0.f;
    const float* wa = w_in_l + (size_t)(tid * 4) * NIN + g * 128;
    for (int c4 = 0; c4 < 128; c4 += 4) {
        f32x4 wr_[4];
#pragma unroll
        for (int r = 0; r < 4; ++r) wr_[r] = *(const f32x4*)(wa + (size_t)r * NIN + c4);
#pragma unroll
        for (int e = 0; e < 4; ++e) {
            const f32x4 m0 = *(const LAS f32x4*)(Mx + (c4 + e) * 16), m1 = *(const LAS f32x4*)(Mx + (c4 + e) * 16 + 4), m2 = *(const LAS f32x4*)(Mx + (c4 + e) * 16 + 8), m3 = *(const LAS f32x4*)(Mx + (c4 + e) * 16 + 12);
#pragma unroll
            for (int r = 0; r < 4; ++r) { const float w = wr_[r][e];
#pragma unroll
                for (int j = 0; j < 4; ++j) { o[r][j] += w * m0[j]; o[r][4 + j] += w * m1[j]; o[r][8 + j] += w * m2[j]; o[r][12 + j] += w * m3[j]; } }
        }
    }
    float mx[16];
#pragma unroll
    for (int j = 0; j < 16; ++j) { mx[j] = fmaxf(fmaxf(fabsf(o[0][j]), fabsf(o[1][j])), fmaxf(fabsf(o[2][j]), fabsf(o[3][j])));
#pragma unroll
        for (int s = 32; s >= 1; s >>= 1) mx[j] = fmaxf(mx[j], __shfl_xor(mx[j], s)); }
    if ((tid & 63) == 0) {
#pragma unroll
        for (int j = 0; j < 16; ++j) rmx[(tid >> 6) * 16 + j] = mx[j]; }
    __syncthreads();
#pragma unroll
    for (int j = 0; j < 16; ++j) {
        float m = 0.f;
#pragma unroll
        for (int w = 0; w < 8; ++w) m = fmaxf(m, rmx[w * 16 + j]);
        m = fmaxf(m, 1e-30f); const float qs = 127.0f / m;
        const int row = part * 512 + g * 128 + dd0 + j;
        if (tid == 0) wsi[row] = m * (1.0f / 127.0f);
        const int q0 = (int)rintf(o[0][j] * qs) & 255, q1 = (int)rintf(o[1][j] * qs) & 255, q2 = (int)rintf(o[2][j] * qs) & 255, q3 = (int)rintf(o[3][j] * qs) & 255;
        *(unsigned*)(win8 + (size_t)row * 4096 + tid * 4) = (unsigned)q0 | ((unsigned)q1 << 8) | ((unsigned)q2 << 16) | ((unsigned)q3 << 24);
    }
    __syncthreads();
}
__device__ __forceinline__ void prep_win8(LAS unsigned char* lds, const float* w_in_l, const float* w_amap_l, signed char* win8, float* wsi) {
    for (int it = blockIdx.x; it < 176; it += gridDim.x) {
        if (it < 64) fold_i8_item(lds, w_in_l, w_amap_l, win8, wsi, it);
        else cols_i8_item(lds, w_in_l + 512, win8 + (size_t)1024 * 4096, wsi + 1024, it - 64);
    }
}
__device__ __forceinline__ void prep_phase(LAS unsigned char* lds, const Args& a) {
    unsigned char* ws = a.ws;
    const int tid = tid_opaque();
    const float* xp = a.in[0]; const float* xs = a.in[1];
    {
        signed char* xb8 = (signed char*)(ws + WS_XB8); float* xsc = (float*)(ws + WS_XSC);
        const int lane = tid & 63, wv = tid >> 6;
        for (int row = blockIdx.x * 8 + wv; row < T; row += gridDim.x * 8) {
            const float* src = (row < TP) ? (xp + (size_t)row * 2048) : (xs + (size_t)(row - TP) * 2048);
            f32x4 v[8]; float mxv = 0.f;
#pragma unroll
            for (int i = 0; i < 8; ++i) { v[i] = *(const f32x4*)(src + i * 256 + lane * 4); mxv = fmaxf(mxv, fmaxf(fmaxf(fabsf(v[i][0]), fabsf(v[i][1])), fmaxf(fabsf(v[i][2]), fabsf(v[i][3])))); }
#pragma unroll
            for (int o = 32; o >= 1; o >>= 1) mxv = fmaxf(mxv, __shfl_xor(mxv, o));
            mxv = fmaxf(mxv, 1e-20f); const float qs = 127.0f / mxv;
            if (lane == 0) xsc[row] = mxv * (1.0f / 127.0f);
#pragma unroll
            for (int i = 0; i < 8; ++i) {
                const int c = i * 256 + lane * 4;
                const int q0 = (int)rintf(v[i][0] * qs), q1 = (int)rintf(v[i][1] * qs), q2 = (int)rintf(v[i][2] * qs), q3 = (int)rintf(v[i][3] * qs);
                *(unsigned*)(xb8 + (size_t)row * X8P + c) = (unsigned)(q0 & 255) | ((unsigned)(q1 & 255) << 8) | ((unsigned)(q2 & 255) << 16) | ((unsigned)(q3 & 255) << 24);
            }
        }
    }
    {
        float* gb = (float*)(ws + WS_CTL) + 512;
        if (blockIdx.x < 2) {
            const int l = blockIdx.x; float g = 0.f, b = 0.f;
            for (int i = tid; i < 2048; i += NTHREADS) { g = fmaxf(g, fabsf(a.in[10][l * 2048 + i])); b = fmaxf(b, fabsf(a.in[11][l * 2048 + i])); }
#pragma unroll
            for (int o = 32; o >= 1; o >>= 1) { g = fmaxf(g, __shfl_xor(g, o)); b = fmaxf(b, __shfl_xor(b, o)); }
            if ((tid & 63) == 0) { atomicMax((unsigned*)(gb + 2 * l), __float_as_uint(g)); atomicMax((unsigned*)(gb + 2 * l + 1), __float_as_uint(b)); }
        }
        for (int it = blockIdx.x; it < 368; it += gridDim.x) {
            if (it < 64) fold_i8_item(lds, a.in[2], a.in[3], (signed char*)(ws + WS_WIN8), (float*)(ws + WS_WSI), it);
            else if (it < 176) cols_i8_item(lds, a.in[2] + 512, (signed char*)(ws + WS_WIN8) + (size_t)1024 * 4096, (float*)(ws + WS_WSI) + 1024, it - 64);
            else { const int l = (it - 176) / 96; cols_i8_item(lds, a.in[2] + (size_t)l * 2048 * NIN + 7680, (signed char*)(ws + WS_WG8) + (size_t)l * 6144 * 4096, (float*)(ws + WS_WSC) + (size_t)l * 6144, (it - 176) % 96); }
        }
    }
    {
        f32x2* rope = (f32x2*)(ws + WS_ROPE);
        for (int idx = blockIdx.x * NTHREADS + tid; idx < 8192 * 8; idx += gridDim.x * NTHREADS) {
            const int pos = idx >> 3, i = idx & 7;
            const float inv = powf(500000.0f, -(float)i * 0.125f);
            const float ang = (float)pos * inv;
            rope[idx] = (f32x2){cosf(ang), sinf(ang)};
        }
    }
    {
        LAS float* ct = (LAS float*)lds;
        for (int m = tid; m < 8192; m += NTHREADS) ct[m] = cospif((float)m * (1.0f / 4096.0f));
        __syncthreads();
        signed char* dp = (signed char*)(ws + WS_DP); signed char* ds = (signed char*)(ws + WS_DS);
        for (int k = blockIdx.x; k < 8192; k += gridDim.x) {
            for (int ch = tid; ch < 1024; ch += NTHREADS) {
                const int col = ch * 8; const int sn = col >= 4096; const int s0 = col & 4095;
                int q[8];
#pragma unroll
                for (int j = 0; j < 8; ++j) { const int mm = (k * (s0 + j)) & 8191; const float v = sn ? -ct[(mm - 2048) & 8191] : ct[mm]; q[j] = (int)rintf(v * 127.0f) & 255; }
                u32x2 w; w.x = (unsigned)q[0] | ((unsigned)q[1] << 8) | ((unsigned)q[2] << 16) | ((unsigned)q[3] << 24); w.y = (unsigned)q[4] | ((unsigned)q[5] << 8) | ((unsigned)q[6] << 16) | ((unsigned)q[7] << 24);
                *(u32x2*)(dp + (size_t)k * 8192 + col) = w;
            }
        }
        for (int k = blockIdx.x; k < 2048; k += gridDim.x) {
            if (tid < 256) { const int col = tid * 8; const int sn = col >= 1024; const int s0 = col & 1023;
                int q[8];
#pragma unroll
                for (int j = 0; j < 8; ++j) { const int mm = (4 * k * (s0 + j)) & 8191; const float v = sn ? -ct[(mm - 2048) & 8191] : ct[mm]; q[j] = (int)rintf(v * 127.0f) & 255; }
                u32x2 w; w.x = (unsigned)q[0] | ((unsigned)q[1] << 8) | ((unsigned)q[2] << 16) | ((unsigned)q[3] << 24); w.y = (unsigned)q[4] | ((unsigned)q[5] << 8) | ((unsigned)q[6] << 16) | ((unsigned)q[7] << 24);
                *(u32x2*)(ds + (size_t)k * 2048 + col) = w; }
        }
        __syncthreads();
    }
    {
        LAS float* buf = (LAS float*)lds;
        const float* wbr = a.in[8]; const float* wo = a.in[9];
        bf16_t* wb = (bf16_t*)(ws + WS_WB); bf16_t* wout = (bf16_t*)(ws + WS_WOUT);
        for (int it = blockIdx.x; it < 6 * 8 * 8; it += gridDim.x) {
            const int lk = it / 64, r = it % 64; const int tr = r & 7, tc = r >> 3;
            transpose_block(buf, wbr + (size_t)lk * 512 * 2048, 2048, wb + (size_t)lk * 2048 * 2048, 2048, tr * 64, tc * 256);
        }
        for (int it = blockIdx.x; it < 2 * 32 * 8; it += gridDim.x) {
            const int l = it / 256, r = it % 256; const int tr = r & 31, tc = r >> 5;
            transpose_block(buf, wo + (size_t)l * 2048 * 2048, 2048, wout + (size_t)l * 2048 * 2048, 2048, tr * 64, tc * 256);
        }
    }
}

__device__ __forceinline__ void pq_fold_row(bf16_t* R, int S, signed char* q8, float* qscale, int lane) {
    const int H = S >> 1; const int nch = H >> 3;
    float mx = 0.f;
    for (int cb = lane; cb < nch; cb += 256) {
        u32x4 pv[4], qv[4], pav[4], qav[4]; unsigned pbv[4], qbv[4];
#pragma unroll
        for (int j = 0; j < 4; ++j) { const int c = cb + 64 * j;
            if (c < nch) { pv[j] = *(const u32x4*)(R + 8 * c); qv[j] = *(const u32x4*)(R + H + 8 * c);
                pav[j] = *(const u32x4*)(R + S + (H - 8 * c - 8)); qav[j] = *(const u32x4*)(R + S + H + (H - 8 * c - 8));
                pbv[j] = 0u; qbv[j] = 0u;
                if (c > 0) { pbv[j] = *(const unsigned short*)(R + S + (H - 8 * c)); qbv[j] = *(const unsigned short*)(R + S + H + (H - 8 * c)); } } }
#pragma unroll
        for (int j = 0; j < 4; ++j) { const int c = cb + 64 * j;
            if (c < nch) {
                const u32x4 p = pv[j], q = qv[j], pa = pav[j], qa = qav[j]; const unsigned pb0 = pbv[j], qb0 = qbv[j];
                const float pf[8] = {bf_lo(p.x), bf_hi(p.x), bf_lo(p.y), bf_hi(p.y), bf_lo(p.z), bf_hi(p.z), bf_lo(p.w), bf_hi(p.w)};
                const float qf[8] = {bf_lo(q.x), bf_hi(q.x), bf_lo(q.y), bf_hi(q.y), bf_lo(q.z), bf_hi(q.z), bf_lo(q.w), bf_hi(q.w)};
                const float paf[8] = {bf_lo(pa.x), bf_hi(pa.x), bf_lo(pa.y), bf_hi(pa.y), bf_lo(pa.z), bf_hi(pa.z), bf_lo(pa.w), bf_hi(pa.w)};
                const float qaf[8] = {bf_lo(qa.x), bf_hi(qa.x), bf_lo(qa.y), bf_hi(qa.y), bf_lo(qa.z), bf_hi(qa.z), bf_lo(qa.w), bf_hi(qa.w)};
                float pe[8], qo[8];
                pe[0] = pf[0] + __uint_as_float(pb0 << 16); qo[0] = (c > 0) ? (qf[0] - __uint_as_float(qb0 << 16)) : 0.f;
#pragma unroll
                for (int e = 1; e < 8; ++e) { pe[e] = pf[e] + paf[8 - e]; qo[e] = qf[e] - qaf[8 - e]; }
#pragma unroll
                for (int e = 0; e < 8; ++e) mx = fmaxf(mx, fmaxf(fabsf(pe[e]), fabsf(qo[e])));
                u32x4 w; w.x = cvt_pk_bf16(pe[0], pe[1]); w.y = cvt_pk_bf16(pe[2], pe[3]); w.z = cvt_pk_bf16(pe[4], pe[5]); w.w = cvt_pk_bf16(pe[6], pe[7]);
                *(u32x4*)(R + 8 * c) = w;
                w.x = cvt_pk_bf16(qo[0], qo[1]); w.y = cvt_pk_bf16(qo[2], qo[3]); w.z = cvt_pk_bf16(qo[4], qo[5]); w.w = cvt_pk_bf16(qo[6], qo[7]);
                *(u32x4*)(R + H + 8 * c) = w;
            } }
    }
#pragma unroll
    for (int o = 32; o >= 1; o >>= 1) mx = fmaxf(mx, __shfl_xor(mx, o));
    mx = fmaxf(mx, 1e-30f); const float qs = 127.0f / mx;
    if (lane == 0) *qscale = mx * (1.0f / 127.0f);
    for (int c = lane; c < nch; c += 64) {
        const u32x4 p = *(const u32x4*)(R + 8 * c), q = *(const u32x4*)(R + H + 8 * c);
        const float pf[8] = {bf_lo(p.x), bf_hi(p.x), bf_lo(p.y), bf_hi(p.y), bf_lo(p.z), bf_hi(p.z), bf_lo(p.w), bf_hi(p.w)};
        const float qf[8] = {bf_lo(q.x), bf_hi(q.x), bf_lo(q.y), bf_hi(q.y), bf_lo(q.z), bf_hi(q.z), bf_lo(q.w), bf_hi(q.w)};
        int a8[8], b8[8];
#pragma unroll
        for (int e = 0; e < 8; ++e) { a8[e] = (int)rintf(pf[e] * qs) & 255; b8[e] = (int)rintf(qf[e] * qs) & 255; }
        u32x2 w; w.x = (unsigned)a8[0] | ((unsigned)a8[1] << 8) | ((unsigned)a8[2] << 16) | ((unsigned)a8[3] << 24); w.y = (unsigned)a8[4] | ((unsigned)a8[5] << 8) | ((unsigned)a8[6] << 16) | ((unsigned)a8[7] << 24);
        *(u32x2*)(q8 + 8 * c) = w;
        w.x = (unsigned)b8[0] | ((unsigned)b8[1] << 8) | ((unsigned)b8[2] << 16) | ((unsigned)b8[3] << 24); w.y = (unsigned)b8[4] | ((unsigned)b8[5] << 8) | ((unsigned)b8[6] << 16) | ((unsigned)b8[7] << 24);
        *(u32x2*)(q8 + H + 8 * c) = w;
    }
}

__device__ __forceinline__ void sgu_item(LAS unsigned char* lds, bf16_t* ys, const bf16_t* vb, const bf16_t* bz, const float* sw, const float* sb, const float* lg, const float* lb, int item, bool dry) {
    const int tid = tid_opaque(), lane = tid & 63, wid = tid >> 6;
    const int cidx = item >> 2, g = item & 3; const int t0 = cidx * 128;
    LAS bf16_t* vT = (LAS bf16_t*)lds;
    {
        const int q = tid >> 2, part = tid & 3;
        const bf16_t* vrow = vb + (size_t)(t0 + q) * 512;
        float s = 0.f, ss = 0.f;
#pragma unroll
        for (int i = 0; i < 16; ++i) {
            const u32x4 z = *(const u32x4*)(vrow + part * 128 + i * 8);
            const float f0 = bf_lo(z.x), f1 = bf_hi(z.x), f2 = bf_lo(z.y), f3 = bf_hi(z.y), f4 = bf_lo(z.z), f5 = bf_hi(z.z), f6 = bf_lo(z.w), f7 = bf_hi(z.w);
            s += ((f0 + f1) + (f2 + f3)) + ((f4 + f5) + (f6 + f7));
            ss += ((f0 * f0 + f1 * f1) + (f2 * f2 + f3 * f3)) + ((f4 * f4 + f5 * f5) + (f6 * f6 + f7 * f7));
        }
        s += __shfl_xor(s, 1); s += __shfl_xor(s, 2); ss += __shfl_xor(ss, 1); ss += __shfl_xor(ss, 2);
        const float mean = s * (1.0f / 512.0f); const float var = fmaxf(ss * (1.0f / 512.0f) - mean * mean, 0.f); const float rstd = rsqrtf(var + LN_EPS);
#pragma unroll
        for (int i = 0; i < 4; ++i) {
            const int c = part * 32 + i * 8;
            const u32x4 z = *(const u32x4*)(vrow + g * 128 + c);
            float f[8] = {bf_lo(z.x), bf_hi(z.x), bf_lo(z.y), bf_hi(z.y), bf_lo(z.z), bf_hi(z.z), bf_lo(z.w), bf_hi(z.w)};
#pragma unroll
            for (int e = 0; e < 8; e += 2) {
                const float y0 = (f[e] - mean) * rstd * lg[g * 128 + c + e] + lb[g * 128 + c + e];
                const float y1 = (f[e + 1] - mean) * rstd * lg[g * 128 + c + e + 1] + lb[g * 128 + c + e + 1];
                const unsigned w = cvt_pk_bf16(y0, y1);
                vT[(c + e) * 136 + q] = (bf16_t)(w & 0xffff); vT[(c + e + 1) * 136 + q] = (bf16_t)(w >> 16);
            }
        }
    }
    __syncthreads();
    {
        const int fr = lane & 15, quad = lane >> 4; const int p = wid * 16 + fr;
        bf16x8 bw[4];
        const float* wrow = sw + ((size_t)g * 128 + p) * 128;
#pragma unroll
        for (int ks = 0; ks < 4; ++ks) {
            const f32x4 a0 = *(const f32x4*)(wrow + ks * 32 + quad * 8), a1 = *(const f32x4*)(wrow + ks * 32 + quad * 8 + 4);
            u32x4 w; w.x = cvt_pk_bf16(a0[0], a0[1]); w.y = cvt_pk_bf16(a0[2], a0[3]); w.z = cvt_pk_bf16(a1[0], a1[1]); w.w = cvt_pk_bf16(a1[2], a1[3]);
            bw[ks] = __builtin_bit_cast(bf16x8, w);
        }
        const float bias = sb[g * 128 + p];
        const int t = t0 + p;
#pragma unroll
        for (int mt = 0; mt < 8; ++mt) {
            f32x4 acc = (f32x4){0.f, 0.f, 0.f, 0.f};
#pragma unroll
            for (int ks = 0; ks < 4; ++ks) {
                const bf16x8 av = *(const LAS bf16x8*)(vT + (16 * mt + fr) * 136 + ks * 32 + quad * 8);
                acc = __builtin_amdgcn_mfma_f32_16x16x32_bf16(av, bw[ks], acc, 0, 0, 0);
            }
            const int c4 = g * 128 + 16 * mt + 4 * quad;
            bf16_t* up = ys + (size_t)t * YLD + 512 + c4;
            const u32x2 uz = *(const u32x2*)up; const u32x2 zz = *(const u32x2*)(bz + (size_t)t * 512 + c4);
            u32x2 w;
            w.x = cvt_pk_bf16(bf_lo(uz.x) * (acc[0] + bias) * bf_lo(zz.x), bf_hi(uz.x) * (acc[1] + bias) * bf_hi(zz.x));
            w.y = cvt_pk_bf16(bf_lo(uz.y) * (acc[2] + bias) * bf_lo(zz.y), bf_hi(uz.y) * (acc[3] + bias) * bf_hi(zz.y));
            if (!dry) *(u32x2*)up = w;
        }
    }
    __syncthreads();
}

struct AttnGeo { int tbase, dil, L, r, m0, gh; };
__device__ __forceinline__ AttnGeo attn_decode(int item) {
    AttnGeo g; g.gh = item % 24; const int ua = item / 24; const int grp = g.gh >> 3;
    int S, u;
    if (ua < 256) { const int sq = ua >> 6; u = ua & 63; S = SP; g.tbase = sq * SP; }
    else { const int v = ua - 256; const int sq = v >> 4; u = v & 15; S = SS; g.tbase = TP + sq * SS; }
    const int dsh = 2 * grp; g.dil = 1 << dsh; g.L = S >> dsh;
    g.r = u & (g.dil - 1); g.m0 = (u >> dsh) * 128;
    return g;
}
__device__ __forceinline__ void attn_phase(LAS unsigned char* lds, bf16_t* qkv, float* lse, int first, int count, int stride, bool dry) {
    const int tid = tid_opaque(), lane = tid & 63, wid = tid >> 6, fr = lane & 15, quad = lane >> 4;
    constexpr int KST = 72;
    LAS bf16_t* Ks = (LAS bf16_t*)lds;
    LAS bf16_t* Vs = (LAS bf16_t*)(lds + 272 * KST * 2);
    u32x4 kz[4], vz[4]; bf16x8 bq[2];
#define ATT_LOAD(item_) do { const AttnGeo g_ = attn_decode(item_); \
        _Pragma("unroll") for (int i = 0; i < 4; ++i) { const int e = tid + 512 * i; const int key = e >> 3, dch = e & 7; const int mk = g_.m0 - 64 + key; const bool ok = (mk >= 0) && (mk < g_.L); \
            kz[i] = (u32x4){0u, 0u, 0u, 0u}; vz[i] = (u32x4){0u, 0u, 0u, 0u}; \
            if (ok) { const bf16_t* rowp = qkv + (size_t)(g_.tbase + mk * g_.dil + g_.r) * 4608 + g_.gh * 64 + dch * 8; kz[i] = *(const u32x4*)(rowp + 1536); vz[i] = *(const u32x4*)(rowp + 3072); } } \
        { const bf16_t* qrow_ = qkv + (size_t)(g_.tbase + (g_.m0 + 16 * wid + fr) * g_.dil + g_.r) * 4608 + g_.gh * 64; \
          bq[0] = *(const bf16x8*)(qrow_ + quad * 8); bq[1] = *(const bf16x8*)(qrow_ + 32 + quad * 8); } } while (0)
    if (count <= 0) return;
    ATT_LOAD(first);
    for (int n = 0; n < count; ++n) {
        const int item = first + n * stride;
        const AttnGeo g = attn_decode(item);
        __syncthreads();
#pragma unroll
        for (int i = 0; i < 4; ++i) { const int e = tid + 512 * i; const int key = e >> 3, dch = e & 7;
            *(LAS u32x4*)(Ks + key * KST + dch * 8) = kz[i]; *(LAS u32x4*)(Vs + key * KST + dch * 8) = vz[i]; }
        if (tid < 128) { const int key = 256 + (tid >> 3), dch = tid & 7;
            *(LAS u32x4*)(Ks + key * KST + dch * 8) = (u32x4){0u, 0u, 0u, 0u}; *(LAS u32x4*)(Vs + key * KST + dch * 8) = (u32x4){0u, 0u, 0u, 0u}; }
        const bf16x8 q0 = bq[0], q1 = bq[1];
        __syncthreads();
        if (n + 1 < count) ATT_LOAD(item + stride);
        const int ql = 16 * wid + fr; const int mq = g.m0 + ql;
        float sc[10][4];
        float mx = -3.0e38f;
        const int klo = max(ql, 64 - g.m0), khi = min(ql + 128, g.L + 63 - g.m0);
        const int kbase = 16 * wid + 4 * quad - klo; const unsigned krng = (unsigned)(khi - klo);
#pragma unroll
        for (int ti = 0; ti < 10; ++ti) {
            const int kk0 = 16 * (wid + ti);
            f32x4 acc = (f32x4){0.f, 0.f, 0.f, 0.f};
            const bf16x8 ka0 = *(const LAS bf16x8*)(Ks + (kk0 + fr) * KST + quad * 8), ka1 = *(const LAS bf16x8*)(Ks + (kk0 + fr) * KST + 32 + quad * 8);
            acc = __builtin_amdgcn_mfma_f32_16x16x32_bf16(ka0, q0, acc, 0, 0, 0);
            acc = __builtin_amdgcn_mfma_f32_16x16x32_bf16(ka1, q1, acc, 0, 0, 0);
#pragma unroll
            for (int j = 0; j < 4; ++j) {
                const bool ok = (unsigned)(kbase + 16 * ti + j) <= krng;
                const float sv = ok ? acc[j] * 0.125f : -1.0e30f;
                sc[ti][j] = sv; mx = fmaxf(mx, sv);
            }
        }
        mx = fmaxf(mx, __shfl_xor(mx, 16)); mx = fmaxf(mx, __shfl_xor(mx, 32));
        float sum = 0.f;
#pragma unroll
        for (int ti = 0; ti < 10; ++ti)
#pragma unroll
            for (int j = 0; j < 4; ++j) { const float p = __builtin_amdgcn_exp2f((sc[ti][j] - mx) * 1.4426950408889634f); sc[ti][j] = p; sum += p; }
        sum += __shfl_xor(sum, 16); sum += __shfl_xor(sum, 32);
        bf16x8 pb[5];
#pragma unroll
        for (int k2 = 0; k2 < 5; ++k2) {
            u32x4 w; w.x = cvt_pk_bf16(sc[2 * k2][0], sc[2 * k2][1]); w.y = cvt_pk_bf16(sc[2 * k2][2], sc[2 * k2][3]);
            w.z = cvt_pk_bf16(sc[2 * k2 + 1][0], sc[2 * k2 + 1][1]); w.w = cvt_pk_bf16(sc[2 * k2 + 1][2], sc[2 * k2 + 1][3]);
            pb[k2] = __builtin_bit_cast(bf16x8, w);
        }
        const float inv = 1.0f / sum;
        bf16_t* qrow = qkv + (size_t)(g.tbase + mq * g.dil + g.r) * 4608 + g.gh * 64;
        const unsigned vbase = (unsigned)(size_t)Vs + (unsigned)(((16 * wid + 4 * quad + (fr >> 2)) * KST + 4 * (fr & 3)) * 2);
#pragma unroll
        for (int mt = 0; mt < 4; ++mt) {
            u32x2 t0, t1, t2, t3, t4, t5, t6, t7, t8, t9;
            const unsigned va = vbase + mt * 32;
            asm volatile("ds_read_b64_tr_b16 %0, %10\n\tds_read_b64_tr_b16 %1, %10 offset:2304\n\tds_read_b64_tr_b16 %2, %10 offset:4608\n\tds_read_b64_tr_b16 %3, %10 offset:6912\n\t"
                         "ds_read_b64_tr_b16 %4, %10 offset:9216\n\tds_read_b64_tr_b16 %5, %10 offset:11520\n\tds_read_b64_tr_b16 %6, %10 offset:13824\n\tds_read_b64_tr_b16 %7, %10 offset:16128\n\t"
                         "ds_read_b64_tr_b16 %8, %10 offset:18432\n\tds_read_b64_tr_b16 %9, %10 offset:20736\n\ts_waitcnt lgkmcnt(0)"
                         : "=&v"(t0), "=&v"(t1), "=&v"(t2), "=&v"(t3), "=&v"(t4), "=&v"(t5), "=&v"(t6), "=&v"(t7), "=&v"(t8), "=&v"(t9) : "v"(va) : "memory");
            f32x4 o = (f32x4){0.f, 0.f, 0.f, 0.f};
            o = __builtin_amdgcn_mfma_f32_16x16x32_bf16(__builtin_bit_cast(bf16x8, ((u32x4){t0.x, t0.y, t1.x, t1.y})), pb[0], o, 0, 0, 0);
            o = __builtin_amdgcn_mfma_f32_16x16x32_bf16(__builtin_bit_cast(bf16x8, ((u32x4){t2.x, t2.y, t3.x, t3.y})), pb[1], o, 0, 0, 0);
            o = __builtin_amdgcn_mfma_f32_16x16x32_bf16(__builtin_bit_cast(bf16x8, ((u32x4){t4.x, t4.y, t5.x, t5.y})), pb[2], o, 0, 0, 0);
            o = __builtin_amdgcn_mfma_f32_16x16x32_bf16(__builtin_bit_cast(bf16x8, ((u32x4){t6.x, t6.y, t7.x, t7.y})), pb[3], o, 0, 0, 0);
            o = __builtin_amdgcn_mfma_f32_16x16x32_bf16(__builtin_bit_cast(bf16x8, ((u32x4){t8.x, t8.y, t9.x, t9.y})), pb[4], o, 0, 0, 0);
            u32x2 w; w.x = cvt_pk_bf16(o[0] * inv, o[1] * inv); w.y = cvt_pk_bf16(o[2] * inv, o[3] * inv);
            if (!dry) *(u32x2*)(qrow + 16 * mt + 4 * quad) = w;
        }
        if (quad == 0 && !dry) lse[(size_t)(g.tbase + mq * g.dil + g.r) * 24 + g.gh] = mx + __logf(sum);
    }
#undef ATT_LOAD
    __syncthreads();
}

__device__ __forceinline__ void combine_phase(bf16_t* ys, const bf16_t* qkv, const float* lse, bool dry) {
    const size_t n = (size_t)T * 64;
    const int tid = tid_opaque();
    const size_t stride = (size_t)gridDim.x * NTHREADS;
    for (size_t id0 = (size_t)blockIdx.x * NTHREADS + tid; id0 < n; id0 += 4 * stride) {
        f32x4 lv[4]; u32x4 o0[4], o1[4], o2[4], zz[4];
#pragma unroll
        for (int j = 0; j < 4; ++j) { const size_t id = id0 + j * stride;
            if (id < n) { const int t = (int)(id >> 6), h = (int)(id >> 3) & 7, ch = (int)id & 7;
                lv[j][0] = lse[(size_t)t * 24 + h]; lv[j][1] = lse[(size_t)t * 24 + 8 + h]; lv[j][2] = lse[(size_t)t * 24 + 16 + h];
                const bf16_t* qr = qkv + (size_t)t * 4608 + h * 64 + ch * 8;
                o0[j] = *(const u32x4*)qr; o1[j] = *(const u32x4*)(qr + 512); o2[j] = *(const u32x4*)(qr + 1024);
                zz[j] = *(const u32x4*)(ys + (size_t)t * YLD + 1024 + h * 64 + ch * 8); } }
#pragma unroll
        for (int j = 0; j < 4; ++j) { const size_t id = id0 + j * stride;
            if (id < n) { const int t = (int)(id >> 6), h = (int)(id >> 3) & 7, ch = (int)id & 7;
                const float l0 = lv[j][0], l1 = lv[j][1], l2 = lv[j][2];
                const float mx = fmaxf(l0, fmaxf(l1, l2));
                float w0 = __expf(l0 - mx), w1 = __expf(l1 - mx), w2 = __expf(l2 - mx);
                const float inv = __builtin_amdgcn_rcpf(w0 + w1 + w2); w0 *= inv; w1 *= inv; w2 *= inv;
                const u32x4 a0 = o0[j], a1 = o1[j], a2 = o2[j], z = zz[j];
                u32x4 w;
                w.x = cvt_pk_bf16((w0 * bf_lo(a0.x) + w1 * bf_lo(a1.x) + w2 * bf_lo(a2.x)) * bf_lo(z.x), (w0 * bf_hi(a0.x) + w1 * bf_hi(a1.x) + w2 * bf_hi(a2.x)) * bf_hi(z.x));
                w.y = cvt_pk_bf16((w0 * bf_lo(a0.y) + w1 * bf_lo(a1.y) + w2 * bf_lo(a2.y)) * bf_lo(z.y), (w0 * bf_hi(a0.y) + w1 * bf_hi(a1.y) + w2 * bf_hi(a2.y)) * bf_hi(z.y));
                w.z = cvt_pk_bf16((w0 * bf_lo(a0.z) + w1 * bf_lo(a1.z) + w2 * bf_lo(a2.z)) * bf_lo(z.z), (w0 * bf_hi(a0.z) + w1 * bf_hi(a1.z) + w2 * bf_hi(a2.z)) * bf_hi(z.z));
                w.w = cvt_pk_bf16((w0 * bf_lo(a0.w) + w1 * bf_lo(a1.w) + w2 * bf_lo(a2.w)) * bf_lo(z.w), (w0 * bf_hi(a0.w) + w1 * bf_hi(a1.w) + w2 * bf_hi(a2.w)) * bf_hi(z.w));
                if (!dry) *(u32x4*)(ys + (size_t)t * YLD + 1024 + h * 64 + ch * 8) = w; } }
    }
}

__device__ __forceinline__ void ln_phase(float* out, bf16_t* xb, const float* lg, const float* lb, bool write_bf, bool dry) {
    const int tid = tid_opaque(); const int lane = tid & 63, wid = tid >> 6;
    for (int row = blockIdx.x * 8 + wid; row < T; row += gridDim.x * 8) {
        float* rp = out + (size_t)row * 2048;
        f32x4 v[8]; float s = 0.f;
#pragma unroll
        for (int i = 0; i < 8; ++i) { v[i] = *(const f32x4*)(rp + i * 256 + lane * 4); s += (v[i][0] + v[i][1]) + (v[i][2] + v[i][3]); }
#pragma unroll
        for (int o = 32; o >= 1; o >>= 1) s += __shfl_xor(s, o);
        const float mean = s * (1.0f / 2048.0f); float q = 0.f;
#pragma unroll
        for (int i = 0; i < 8; ++i) { const f32x4 d = v[i] - mean; q += (d[0] * d[0] + d[1] * d[1]) + (d[2] * d[2] + d[3] * d[3]); }
#pragma unroll
        for (int o = 32; o >= 1; o >>= 1) q += __shfl_xor(q, o);
        const float rstd = rsqrtf(q * (1.0f / 2048.0f) + LN_EPS);
#pragma unroll
        for (int i = 0; i < 8; ++i) {
            const int c = i * 256 + lane * 4;
            const f32x4 gg = *(const f32x4*)(lg + c), bb = *(const f32x4*)(lb + c);
            const f32x4 y = (v[i] - mean) * rstd * gg + bb;
            if (!dry) *(f32x4*)(rp + c) = y;
            if (write_bf && !dry) { u32x2 w; w.x = cvt_pk_bf16(y[0], y[1]); w.y = cvt_pk_bf16(y[2], y[3]); *(u32x2*)(xb + (size_t)row * 2048 + c) = w; }
        }
    }
}

__global__ void __launch_bounds__(NTHREADS) fwd_kernel(Args a) {
    extern __shared__ __attribute__((aligned(16))) unsigned char lds_raw[];
    LAS unsigned char* lds = (LAS unsigned char*)lds_raw;
    unsigned char* ws = a.ws;
    const int G = gridDim.x, c_blk = blockIdx.x;
    const int lo = a.ph_lo, hi = a.ph_hi;
#ifndef P2SUB
#define P2SUB 0xf
#endif
#ifndef PMASK
#define PMASK 0xff
#endif
#if SINGLE_LAUNCH
#define IN(k) (true)
#else
#define IN(k) (lo <= (k) && (k) < hi)
#endif
#define SEAM(k) do { if (IN(k) && IN((k) + 1)) { if (a.ph_lo == 0x7fffff01) cg::this_grid().sync();   ++nbar; grid_bar(ctl, nbar * (unsigned)G); } } while (0)
    unsigned nbar = 0;
    bf16_t* xb = (bf16_t*)(ws + WS_XB); bf16_t* win = (bf16_t*)(ws + WS_WIN);
    bf16_t* ys = (bf16_t*)(ws + WS_YS); bf16_t* vb = (bf16_t*)(ws + WS_VB); bf16_t* bzb = (bf16_t*)(ws + WS_BZ);
    bf16_t* qkv = (bf16_t*)(ws + WS_QKV); float* lse = (float*)(ws + WS_LSE);
    bf16_t* merged = (bf16_t*)(ws + WS_MERGED);
    unsigned* ctl = (unsigned*)(ws + WS_CTL);
    LAS int* qslot = (LAS int*)(lds + 128 * 1024);

    if (IN(0) && (PMASK & 1)) { prep_phase(lds, a); }
    SEAM(0);
#pragma nounroll
    for (int l = 0; l < 2; ++l) {
        const int pb = 1 + 6 * l;
        int c = c_blk; asm volatile("" : "+s"(c));
        if (IN(pb) && (PMASK & 2)) {
            { SchedIn8 S{(const char*)(ws + WS_XB8), (const char*)(ws + WS_WIN8), G, c};
              EpiIn<true> E{ys, vb, bzb, qkv, (bf16_t*)(ws + WS_PQTP), (bf16_t*)(ws + WS_PQTS), (const f32x2*)(ws + WS_ROPE), (const float*)(ws + WS_XSC), (const float*)(ws + WS_WSI)};
              pg8::gemm_phase<EpiIn<true>, SchedIn8, true>(lds, X8P / 2, 2048, S, E); }
        }
        SEAM(pb);
        if (IN(pb + 1)) {
            const int tidf = tid_opaque(); const int lane = tidf & 63;
            for (int row = c * 8 + (tidf >> 6); row < 2048; row += G * 8) {
                pq_fold_row((bf16_t*)(ws + WS_PQTP) + (size_t)row * 16384, SP, (signed char*)(ws + WS_PQ8P) + (size_t)row * 8192, (float*)(ws + WS_QSC) + row, lane);
                pq_fold_row((bf16_t*)(ws + WS_PQTS) + (size_t)row * 4096, SS, (signed char*)(ws + WS_PQ8S) + (size_t)row * 2048, (float*)(ws + WS_QSC) + 2048 + row, lane);
            }
        }
        SEAM(pb + 1);
        if (IN(pb + 2) && (PMASK & 4)) {
            {
            const bool dry = false;
            EpiDft E{ys, (const bf16_t*)(ws + WS_PQTP), (const bf16_t*)(ws + WS_PQTS), dry, (const float*)(ws + WS_QSC)};
            if (P2SUB & 1) { SchedDftP S{(const char*)(ws + WS_DP), (const char*)(ws + WS_PQ8P), G, c}; pg8::gemm_phase<EpiDft, SchedDftP, true>(lds, 4096, 4096, S, E); }
            if (P2SUB & 2) { SchedDftS S{(const char*)(ws + WS_DS), (const char*)(ws + WS_PQ8S), G, c}; pg8::gemm_phase<EpiDft, SchedDftS, true>(lds, 1024, 1024, S, E); }
            const float* sw = a.in[6] + (size_t)l * 4 * 128 * 128; const float* sb = a.in[7] + (size_t)l * 4 * 128;
            const float* slg = a.in[4] + (size_t)l * 512; const float* slb = a.in[5] + (size_t)l * 512;
            constexpr int N_SGU = (T / 128) * 4, N_ATT = (T / 128) * 24;
            if (P2SUB & 4) for (int item = c; item < N_SGU; item += G) sgu_item(lds, ys, vb, bzb, sw, sb, slg, slb, item, dry);
            if (P2SUB & 8) {
                if (G == 256) { const int first = c < 64 ? c * 27 : 1728 + (c - 64) * 31; attn_phase(lds, qkv, lse, first, c < 64 ? 27 : 31, 1, dry); }
                else attn_phase(lds, qkv, lse, c, (N_ATT - c + G - 1) / G, G, dry);
            }
            }
        }
        SEAM(pb + 2);
        if (IN(pb + 3) && (PMASK & 8)) {
            combine_phase(ys, qkv, lse, false);
        }
        SEAM(pb + 3);
        if (IN(pb + 4) && (PMASK & 16)) {
            unsigned char* scr = ws + WS_SCR + (size_t)c * SCR_PER_WG;
            EpiGate EG{(u32x4*)scr, (const float*)(ws + WS_XSC), (const float*)(ws + WS_WSC) + (size_t)l * 6144};
            EpiProj EP{(const u32x4*)scr, merged};
#pragma nounroll
            for (int ti = 0; ti < (T / 256) * 8; ti += G) {
                int pm = 0, pn = 0; const bool ok = pg8::grid_tile(ti + c, T / 256, 8, pm, pn);
                SchedGate SG{(const char*)(ws + WS_XB8), (const char*)(ws + WS_WG8 + (size_t)l * 6144 * 4096), pm, pn, ok};
                pg8::gemm_phase<EpiGate, SchedGate, true>(lds, X8P / 2, 2048, SG, EG);
                SchedProj SPj{(const char*)ys, (const char*)(ws + WS_WB + (size_t)l * 3 * 2048 * 2048 * 2), pm, pn, ok};
                pg8::gemm_phase<EpiProj, SchedProj>(lds, YLD, 2048, SPj, EP);
            }
        }
        SEAM(pb + 4);
        if (IN(pb + 5) && (PMASK & 32)) {
            {
                SchedOutLn S{(const char*)merged, (const char*)(ws + WS_WOUT + (size_t)l * 2048 * 2048 * 2), c};
                EpiOutLn E{l == 0 ? a.in[0] : a.out, l == 0 ? a.in[1] : (a.out + (size_t)TP * 2048), a.out, (bf16_t*)nullptr,
                           a.in[10] + (size_t)l * 2048, a.in[11] + (size_t)l * 2048,
                           (unsigned long long*)(ws + WS_XCH) + (size_t)l * 160 * 256 * 16, ctl + 64 + l * 160, lds + 128 * 1024 + 256,
                           l == 0 ? (signed char*)(ws + WS_XB8) : (signed char*)nullptr, (float*)(ws + WS_XSC), (const float*)(ws + WS_CTL) + 512 + 2 * l};
                pg8::gemm_phase<EpiOutLn, SchedOutLn>(lds, 2048, 2048, S, E);
            }
            if (l == 0) {
                prep_win8(lds, a.in[2] + (size_t)2048 * NIN, a.in[3] + (size_t)4 * 128 * 128, (signed char*)(ws + WS_WIN8), (float*)(ws + WS_WSI));
            }
        }
        if (l == 0) SEAM(pb + 5);
    }
#undef IN
#undef SEAM
}

constexpr int N_PHASES = 13;
__global__ void fill_kernel(float* p, size_t n, float v) { for (size_t i = (size_t)blockIdx.x * blockDim.x + threadIdx.x; i < n; i += (size_t)gridDim.x * blockDim.x) p[i] = v; }

extern "C" void kernel_launch(void* const* d_in, const int* in_sizes, int n_in, void* d_out, int out_size, void* d_ws, size_t ws_size, hipStream_t stream) {
    static int grid = 0;
    if (grid == 0) {
        int dev = 0, cus = 0, per_cu = 0;
        hipGetDevice(&dev);
        hipDeviceGetAttribute(&cus, hipDeviceAttributeMultiprocessorCount, dev);
        if (hipFuncSetAttribute((const void*)fwd_kernel, hipFuncAttributeMaxDynamicSharedMemorySize, LDS_BYTES) != hipSuccess) fprintf(stderr, "kernel_launch: hipFuncSetAttribute failed\n");
        hipOccupancyMaxActiveBlocksPerMultiprocessor(&per_cu, (const void*)fwd_kernel, NTHREADS, LDS_BYTES);
        if (per_cu < 1) { fprintf(stderr, "kernel_launch: occupancy query says %d blocks per CU\n", per_cu); per_cu = 1; }
        (void)hipGetLastError();
        grid = 256;
        if (cus != 256) fprintf(stderr, "kernel_launch: built for 256 CUs, device reports %d\n", cus);
        if (ws_size < WS_END) fprintf(stderr, "kernel_launch: workspace too small: %zu < %zu\n", ws_size, (size_t)WS_END);
    }
    if (ws_size < WS_END) { hipLaunchKernelGGL(fill_kernel, dim3(1024), dim3(256), 0, stream, (float*)d_out, (size_t)out_size, (float)((double)ws_size / 268435456.0)); return; }
    hipMemsetAsync((char*)d_ws + WS_CTL, 0, 4096, stream);
    Args a{};
    for (int i = 0; i < 12; ++i) a.in[i] = (const float*)d_in[i];
    a.out = (float*)d_out; a.ws = (unsigned char*)d_ws;
    { const int reps[6] = {PROBE_REPS}; for (int i = 0; i < 6; ++i) a.rep[i] = reps[i]; }
#if SINGLE_LAUNCH
    a.ph_lo = 0; a.ph_hi = N_PHASES;
    void* args[] = {&a};
    hipError_t e = hipLaunchCooperativeKernel((const void*)fwd_kernel, dim3(grid), dim3(NTHREADS), args, LDS_BYTES, stream);
    if (e != hipSuccess) fprintf(stderr, "cooperative launch failed: %s (grid %d)\n", hipGetErrorString(e), grid);
#else
    for (int p = 0; p < N_PHASES; ++p) {
        a.ph_lo = p; a.ph_hi = p + 1;
        hipLaunchKernelGGL(fwd_kernel, dim3(grid), dim3(NTHREADS), LDS_BYTES, stream, a);
    }
#endif
}
```

```cpp
#include <hip/hip_runtime.h>
#include <hip/hip_cooperative_groups.h>
#include <cstdio>
namespace cg = cooperative_groups;

#ifndef STAG1
#define STAG1 0
#endif
#ifndef STAG3
#define STAG3 0
#endif
#ifndef PROBE_REPS
#define PROBE_REPS 0, 0, 0, 0, 0, 0
#endif
#ifndef SINGLE_LAUNCH
#define SINGLE_LAUNCH 1
#endif

#define LAS __attribute__((address_space(3)))
typedef unsigned short bf16_t;
typedef short bf16x8 __attribute__((ext_vector_type(8)));
typedef short bf16x4 __attribute__((ext_vector_type(4)));
typedef float f32x4 __attribute__((ext_vector_type(4)));
typedef float f32x2 __attribute__((ext_vector_type(2)));
typedef unsigned u32x4 __attribute__((ext_vector_type(4)));
typedef unsigned u32x2 __attribute__((ext_vector_type(2)));
typedef int i32x4 __attribute__((ext_vector_type(4)));

constexpr int T = 40960, TP = 32768, DM = 2048;
constexpr int SP = 8192, SS = 2048;
constexpr int NW = 14336;
constexpr int NIN = 13824;
constexpr int NTHREADS = 512;
constexpr float ALPHA = 1.41421356237309515f;
constexpr float LN_EPS = 1e-5f;

constexpr size_t al256(size_t x) { return (x + 255) & ~(size_t)255; }
constexpr size_t WS_CTL = 0;
constexpr size_t WS_ROPE = WS_CTL + 4096;
constexpr size_t WS_XB = WS_ROPE + al256((size_t)8192 * 8 * 8);
constexpr size_t WS_WIN = WS_XB + 256;
constexpr int NWB = 0;
constexpr size_t WS_WB = WS_WIN + (size_t)NWB * 2048 * 2;
constexpr size_t WS_WOUT = WS_WB + (size_t)2 * 3 * 2048 * 2048 * 2;
constexpr size_t WS_DP = WS_WOUT + (size_t)2 * 2048 * 2048 * 2;
constexpr size_t WS_DS = WS_DP + (size_t)8192 * 8192;
constexpr size_t WS_PQTP = WS_DS + (size_t)2048 * 2048;
constexpr size_t WS_PQTS = WS_PQTP + (size_t)4 * 512 * 16384 * 2;
constexpr size_t WS_YS = WS_PQTS + (size_t)4 * 512 * 4096 * 2;
constexpr int YLD = 1536;
constexpr size_t WS_VB = WS_YS + (size_t)T * YLD * 2;
constexpr size_t WS_BZ = WS_VB + (size_t)T * 512 * 2;
constexpr size_t WS_QKV = WS_BZ + (size_t)T * 512 * 2;
constexpr size_t WS_MERGED = WS_QKV;
constexpr size_t WS_SCR = WS_MERGED + (size_t)T * 2048 * 2;
constexpr size_t SCR_PER_WG = 384 * 1024;
constexpr size_t WS_LSE = WS_QKV + (size_t)T * 4608 * 2;
constexpr size_t WS_XCH = WS_LSE + (size_t)T * 24 * 4;
constexpr size_t WS_XB8 = WS_XCH + (size_t)2 * 160 * 256 * 8 * 16;
constexpr int X8P = 3072;
constexpr size_t WS_XSC = WS_XB8 + (size_t)T * X8P;
constexpr size_t WS_WG8 = WS_XSC + (size_t)T * 4;
constexpr size_t WS_WSC = WS_WG8 + (size_t)2 * 6144 * 4096;
constexpr size_t WS_WIN8 = WS_WSC + (size_t)2 * 6144 * 4;
constexpr size_t WS_WSI = WS_WIN8 + (size_t)8192 * 4096;
constexpr size_t WS_PQ8P = WS_WSI + (size_t)8192 * 4;
constexpr size_t WS_PQ8S = WS_PQ8P + (size_t)2048 * 8192;
constexpr size_t WS_QSC = WS_PQ8S + (size_t)2048 * 2048;
constexpr size_t WS_END = WS_QSC + (size_t)4096 * 4;
static_assert(WS_SCR + 256 * SCR_PER_WG <= WS_LSE, "scratch alias");

constexpr int LDS_BYTES = 128 * 1024 + 256 + 15360 + 256 + 2048;

__device__ __forceinline__ unsigned cvt_pk_bf16(float lo, float hi) { unsigned r; asm("v_cvt_pk_bf16_f32 %0, %1, %2" : "=v"(r) : "v"(lo), "v"(hi)); return r; }
__device__ __forceinline__ float bf_lo(unsigned w) { return __uint_as_float(w << 16); }
__device__ __forceinline__ float bf_hi(unsigned w) { return __uint_as_float(w & 0xffff0000u); }
__device__ __forceinline__ float bf1(bf16_t b) { return __uint_as_float(((unsigned)b) << 16); }
__device__ __forceinline__ float sigmoid_f(float x) { return __builtin_amdgcn_rcpf(1.0f + __expf(-x)); }
__device__ __forceinline__ float silu_f(float x) { return x * sigmoid_f(x); }
__device__ __forceinline__ float gelu_f(float x) { const float y = 1.5957691216057308f * (x + 0.044715f * x * x * x); return x * sigmoid_f(y); }


__device__ __forceinline__ void stagger_wait(int ticks) {
    if (ticks <= 0) return;
    const unsigned long long t0 = __builtin_amdgcn_s_memrealtime();
    while (__builtin_amdgcn_s_memrealtime() - t0 < (unsigned long long)ticks) __builtin_amdgcn_s_sleep(8);
}

__device__ __forceinline__ int tid_opaque() { int t = threadIdx.x; asm volatile("" : "+v"(t)); return t; }
__device__ __forceinline__ void grid_bar(unsigned* ctr, unsigned target) {
    __syncthreads();
    if (tid_opaque() == 0) {
        __builtin_amdgcn_fence(__ATOMIC_RELEASE, "agent");
        __hip_atomic_fetch_add(ctr, 1u, __ATOMIC_RELAXED, __HIP_MEMORY_SCOPE_AGENT);
        while (__hip_atomic_load(ctr, __ATOMIC_RELAXED, __HIP_MEMORY_SCOPE_AGENT) < target) __builtin_amdgcn_s_sleep(1);
        __builtin_amdgcn_fence(__ATOMIC_ACQUIRE, "agent");
    }
    __syncthreads();
}

struct Args {
    const float* in[12];
    float* out;
    unsigned char* ws;
    int ph_lo, ph_hi;
    int rep[6];
};

namespace pg8 {
constexpr int BM = 256, BK = 64, HALF = 128, HTB = HALF * BK * 2, STAGE_BYTES = 8 * HTB;
__device__ __forceinline__ int lds_byte(int r, int c) { const int st = (r >> 4) * 2 + (c >> 5), rr = r & 15, cc = c & 31, ob = rr * 64 + cc * 2; return st * 1024 + (ob ^ (((ob >> 9) & 1) << 5)); }
__device__ __forceinline__ void stage_rc(int b, int& R, int& C) { const int st = b / 1024, sb = b % 1024, swz = sb ^ (((sb >> 9) & 1) << 5); R = (st >> 1) * 16 + swz / 64; C = (st & 1) * 32 + (swz % 64) / 2; }
__device__ __forceinline__ int perm32(int rho) { const int n = rho >> 4, i = rho & 15; return 8 * (i >> 2) + 4 * n + (i & 3); }

struct Unit { const char* A; const char* B; int nt, pm, pn, aux; };

__device__ __forceinline__ bool grid_tile(int L, int nM, int nN, int& pm, int& pn) {
    const int nwg = nM * nN; if (L >= nwg) return false;
    int wgid = L; { const int q = nwg / 8, r = nwg % 8, xcd = wgid % 8, off = wgid / 8; wgid = (xcd < r ? xcd * (q + 1) : r * (q + 1) + (xcd - r) * q) + off; }
    const int nig = 8 * nN, gid = wgid / nig, fm = gid * 8, gsz = (nM - fm) < 8 ? (nM - fm) : 8;
    pm = fm + ((wgid % nig) % gsz); pn = (wgid % nig) / gsz; return true;
}

template <class Epi, class Sched, bool HAS_I8 = false>
__device__ __forceinline__ void gemm_phase(LAS unsigned char* lds, const int lda, const int ldb, const Sched& S, const Epi& E) {
    const int tid = tid_opaque(), wid = __builtin_amdgcn_readfirstlane(tid >> 6), lane = tid & 63, wr = wid >> 2, wc = wid & 3, fr = lane & 15, fq = lane >> 4;
    unsigned voffA[2], voffB[2];
#pragma unroll
    for (int i = 0; i < 2; ++i) { int R, C; stage_rc(tid * 16 + i * 8192, R, C); const int Rb = Epi::PERM ? ((R & ~31) + perm32(R & 31)) : R;
        voffA[i] = (unsigned)(R * lda + C) * 2u; voffB[i] = (unsigned)(Rb * ldb + C) * 2u; }
    const size_t kstep = (size_t)(BK * 2);
    const size_t hstepA = (size_t)HALF * lda * 2, hstepB = (size_t)HALF * ldb * 2;
    const unsigned ldsw = (unsigned)wid * 1024u;
    const int aoff = lds_byte(wr * 64 + fr, fq * 8), boff = lds_byte(wc * 32 + fr, fq * 8);
#define PG8_SA(b, h) (((b) * 2 + (h)) * HTB)
#define PG8_SB(b, h) ((4 + (b) * 2 + (h)) * HTB)
#define PG8_STAGE(bufoff, gbase, voff) do { _Pragma("unroll") for (int _i = 0; _i < 2; ++_i) \
        __builtin_amdgcn_global_load_lds((const unsigned*)((const char*)(gbase) + (voff)[_i]), (LAS unsigned*)(lds + (bufoff) + ldsw + _i * 8192), 16, 0, 0); } while (0)
#define PG8_LDA(dst, b, h) do { _Pragma("unroll") for (int m = 0; m < 4; ++m) _Pragma("unroll") for (int k = 0; k < 2; ++k) dst[m][k] = *(const LAS bf16x8*)(lds + PG8_SA(b, h) + aoff + m * 2048 + k * 1024); } while (0)
#define PG8_LDB(dst, b, h) do { _Pragma("unroll") for (int n = 0; n < 2; ++n) _Pragma("unroll") for (int k = 0; k < 2; ++k) dst[n][k] = *(const LAS bf16x8*)(lds + PG8_SB(b, h) + boff + n * 2048 + k * 1024); } while (0)
#define PG8_MMA(ai, bj, At, Bt) do { __builtin_amdgcn_s_setprio(1); \
        if (i8u) { _Pragma("unroll") for (int m = 0; m < 4; ++m) _Pragma("unroll") for (int n = 0; n < 2; ++n) _Pragma("unroll") for (int k = 0; k < 2; ++k) \
            acc[ai][bj][m][n] = __builtin_bit_cast(f32x4, __builtin_amdgcn_mfma_i32_16x16x64_i8(__builtin_bit_cast(i32x4, Bt[n][k]), __builtin_bit_cast(i32x4, At[m][k]), __builtin_bit_cast(i32x4, acc[ai][bj][m][n]), 0, 0, 0)); } \
        else { _Pragma("unroll") for (int m = 0; m < 4; ++m) _Pragma("unroll") for (int n = 0; n < 2; ++n) _Pragma("unroll") for (int k = 0; k < 2; ++k) \
            acc[ai][bj][m][n] = __builtin_amdgcn_mfma_f32_16x16x32_bf16(Bt[n][k], At[m][k], acc[ai][bj][m][n], 0, 0, 0); } \
        __builtin_amdgcn_s_setprio(0); } while (0)
#define PG8_WAIT_V(n) asm volatile("s_waitcnt vmcnt(" #n ")" ::: "memory")
#define PG8_WAIT_L(n) asm volatile("s_waitcnt lgkmcnt(" #n ")" ::: "memory")
#define PG8_BAR __builtin_amdgcn_s_barrier()
#define PG8_SCHED __builtin_amdgcn_sched_barrier(0)
    Unit cur, nxt; int ui = 0;
    if (!S.next(0, cur)) return;
    f32x4 acc[2][2][4][2];
#pragma unroll
    for (int a = 0; a < 2; ++a)
#pragma unroll
        for (int b = 0; b < 2; ++b)
#pragma unroll
            for (int m = 0; m < 4; ++m)
#pragma unroll
                for (int n = 0; n < 2; ++n) acc[a][b][m][n] = (f32x4){0.f, 0.f, 0.f, 0.f};
    bf16x8 At[4][2], B0[2][2], B1[2][2];
    const char* cA = cur.A; const char* cB = cur.B;
    PG8_STAGE(PG8_SB(0, 0), cB, voffB); PG8_STAGE(PG8_SB(0, 1), cB + hstepB, voffB); PG8_STAGE(PG8_SA(0, 0), cA, voffA); PG8_STAGE(PG8_SA(0, 1), cA + hstepA, voffA);
    if (wr == 1) PG8_BAR;
    PG8_WAIT_V(2); PG8_BAR;
    PG8_STAGE(PG8_SB(1, 0), cB + kstep, voffB); PG8_STAGE(PG8_SA(1, 0), cA + kstep, voffA); PG8_STAGE(PG8_SB(1, 1), cB + hstepB + kstep, voffB);
    PG8_WAIT_V(6); PG8_BAR;
    for (;;) {
        const bool has_next = S.next(ui + 1, nxt);
        const char* nA = has_next ? nxt.A : cA; const char* nB = has_next ? nxt.B : cB;
        const int nt = cur.nt;
        constexpr bool i8u = HAS_I8;
        for (int t = 0; t < nt; t += 2) {
            const bool last = (t == nt - 2);
            const char* a1 = cA + (size_t)(t + 1) * kstep;
            const char* a2 = last ? nA : cA + (size_t)(t + 2) * kstep; const char* b2 = last ? nB : cB + (size_t)(t + 2) * kstep;
            const char* a3 = a2 + kstep; const char* b3 = b2 + kstep;
            PG8_LDB(B0, 0, 0); PG8_LDB(B1, 0, 1); PG8_SCHED; PG8_LDA(At, 0, 0); PG8_STAGE(PG8_SA(1, 1), a1 + hstepA, voffA);
            PG8_WAIT_V(8); PG8_WAIT_L(0); PG8_BAR; PG8_MMA(0, 0, At, B0); PG8_MMA(0, 1, At, B1); PG8_BAR; PG8_SCHED;
            PG8_LDA(At, 0, 1); PG8_STAGE(PG8_SB(0, 0), b2, voffB); PG8_STAGE(PG8_SB(0, 1), b2 + hstepB, voffB); PG8_STAGE(PG8_SA(0, 0), a2, voffA);
            PG8_WAIT_V(8); PG8_WAIT_L(0); PG8_BAR; PG8_MMA(1, 0, At, B0); PG8_MMA(1, 1, At, B1); PG8_BAR; PG8_SCHED;
            PG8_LDB(B0, 1, 0); PG8_LDB(B1, 1, 1); PG8_SCHED; PG8_LDA(At, 1, 0); PG8_STAGE(PG8_SA(0, 1), a2 + hstepA, voffA);
            PG8_WAIT_V(8); PG8_WAIT_L(0); PG8_BAR; PG8_MMA(0, 0, At, B0); PG8_MMA(0, 1, At, B1); PG8_BAR; PG8_SCHED;
            PG8_LDA(At, 1, 1); PG8_STAGE(PG8_SB(1, 0), b3, voffB); PG8_STAGE(PG8_SB(1, 1), b3 + hstepB, voffB); PG8_STAGE(PG8_SA(1, 0), a3, voffA);
            PG8_WAIT_V(8); PG8_WAIT_L(0); PG8_BAR; PG8_MMA(1, 0, At, B0); PG8_MMA(1, 1, At, B1); PG8_BAR; PG8_SCHED;
        }
        if (wr == 0) PG8_BAR;
        E(acc, cur, wr, wc, fr, fq);
        if (!has_next) break;
        if (!(nxt.aux & 256)) {
#pragma unroll
        for (int a = 0; a < 2; ++a)
#pragma unroll
            for (int b = 0; b < 2; ++b)
#pragma unroll
                for (int m = 0; m < 4; ++m)
#pragma unroll
                    for (int n = 0; n < 2; ++n) acc[a][b][m][n] = (f32x4){0.f, 0.f, 0.f, 0.f};
        }
        cur = nxt; cA = nA; cB = nB; ++ui;
        if (wr == 1) PG8_BAR;
    }
    PG8_WAIT_V(0);
    PG8_BAR;
#undef PG8_SA
#undef PG8_SB
#undef PG8_STAGE
#undef PG8_LDA
#undef PG8_LDB
#undef PG8_MMA
#undef PG8_WAIT_V
#undef PG8_WAIT_L
#undef PG8_BAR
#undef PG8_SCHED
}
}
using pg8::Unit;

struct SchedInPQ {
    const char* A; const char* B; int G, c;
    __device__ __forceinline__ bool next(int i, Unit& u) const {
        int pm, pn; if (!pg8::grid_tile(i * G + c, T / 256, 4, pm, pn)) return false;
        u.A = A + (size_t)pm * 256 * 2048 * 2; u.B = B + (size_t)pn * 256 * 2048 * 2; u.nt = 32; u.pm = pm; u.pn = pn; u.aux = 0; return true;
    }
};
struct SchedIn8 {
    const char* A; const char* B; int G, c;
    __device__ __forceinline__ bool next(int i, Unit& u) const {
        int pm, pn; if (!pg8::grid_tile(i * G + c, T / 256, 32, pm, pn)) return false;
        u.A = A + (size_t)pm * 256 * X8P; u.B = B + (size_t)pn * 256 * 4096; u.nt = 16; u.pm = pm; u.pn = pn; u.aux = 0; return true;
    }
};
struct SchedDftP {
    const char* A; const char* B; int G, c;
    __device__ __forceinline__ bool next(int i, Unit& u) const {
        const int L = i * G + c; if (L >= 256) return false;
        const int x = L & 7, o = L >> 3; u.pm = 4 * x + (o & 3); u.pn = o >> 2; u.aux = 0; u.nt = 64;
        u.A = A + (size_t)u.pm * 256 * 8192; u.B = B + (size_t)u.pn * 256 * 8192; return true;
    }
};
struct SchedDftS {
    const char* A; const char* B; int G, c;
    __device__ __forceinline__ bool next(int i, Unit& u) const {
        const int L = i * G + c; if (L >= 64) return false;
        u.pm = L & 7; u.pn = L >> 3; u.aux = 1; u.nt = 16;
        u.A = A + (size_t)u.pm * 256 * 2048; u.B = B + (size_t)u.pn * 256 * 2048; return true;
    }
};
struct SchedGate {
    const char* X8; const char* WG8p; int pm, pn; bool ok;
    __device__ __forceinline__ bool next(int i, Unit& u) const {
        if (!ok || i >= 3) return false;
        u.pm = pm; u.pn = pn; u.aux = i; u.nt = 16; u.A = X8 + (size_t)pm * 256 * X8P; u.B = WG8p + ((size_t)i * 2048 + (size_t)pn * 256) * 4096; return true;
    }
};
struct SchedProj {
    const char* Y; const char* WBp; int pm, pn; bool ok;
    __device__ __forceinline__ bool next(int i, Unit& u) const {
        if (!ok || i >= 3) return false;
        u.pm = pm; u.pn = pn; u.aux = i | (i > 0 ? 256 : 0); u.nt = 8;
        u.A = Y + ((size_t)pm * 256 * YLD + (size_t)i * 512) * 2; u.B = WBp + ((size_t)i * 2048 + (size_t)pn * 256) * 2048 * 2; return true;
    }
};
struct SchedOut {
    const char* A; const char* B; int G, c;
    __device__ __forceinline__ bool next(int i, Unit& u) const {
        int pm, pn; if (!pg8::grid_tile(i * G + c, T / 256, 8, pm, pn)) return false;
        u.A = A + (size_t)pm * 256 * 2048 * 2; u.B = B + (size_t)pn * 256 * 2048 * 2; u.nt = 32; u.pm = pm; u.pn = pn; u.aux = 0; return true;
    }
};

template <bool I8> struct EpiIn {
    static constexpr bool PERM = true;
    bf16_t *ys, *vb, *bz, *qkv, *pqtp, *pqts; const f32x2* rope; const float* xsc; const float* wsi;
    __device__ __forceinline__ void operator()(const f32x4 (&acc)[2][2][4][2], const Unit& u, int wr, int wc, int fr, int fq) const {
        const int pn = u.pn;
        const int row0 = u.pm * 256 + wr * 64 + fr;
        const int cl0 = wc * 32 + 8 * fq;
        if (pn < 4) {
            const int part = pn >> 1; const int j0 = (pn & 1) * 256 + cl0;
            bf16_t* base; size_t ldj; int srow0;
            const int trow = u.pm * 256;
            if (trow < TP) { const int seq = trow >> 13; ldj = 16384; const int sl = trow & 8191; const int hi = sl >> 12;
                base = pqtp + (size_t)seq * 512 * 16384 + (size_t)(2 * hi + part) * 4096; srow0 = row0 - (seq << 13) - (hi << 12); }
            else { const int t2 = trow - TP; const int seq = t2 >> 11; ldj = 4096; const int sl = t2 & 2047; const int hi = sl >> 10;
                base = pqts + (size_t)seq * 512 * 4096 + (size_t)(2 * hi + part) * 1024; srow0 = row0 - TP - (seq << 11) - (hi << 10); }
#pragma unroll
            for (int ai = 0; ai < 2; ++ai) {
                float rsv[4];
                if (I8) {
#pragma unroll
                    for (int g = 0; g < 4; ++g) rsv[g] = xsc[row0 + ai * 128 + g * 16];
                }
#pragma unroll
                for (int m = 0; m < 4; ++m) {
                    const int s = srow0 + ai * 128 + m * 16;
#pragma unroll
                    for (int bj = 0; bj < 2; ++bj) {
                        f32x4 v0 = acc[ai][bj][m][0], v1 = acc[ai][bj][m][1];
                        if (I8) { const float rs = rsv[m];
                            const f32x4 w0 = *(const f32x4*)(wsi + pn * 256 + bj * 128 + cl0), w1 = *(const f32x4*)(wsi + pn * 256 + bj * 128 + cl0 + 4);
                            const i32x4 i0 = __builtin_bit_cast(i32x4, v0), i1 = __builtin_bit_cast(i32x4, v1);
#pragma unroll
                            for (int i = 0; i < 4; ++i) { v0[i] = (float)i0[i] * (rs * w0[i]); v1[i] = (float)i1[i] * (rs * w1[i]); } }
                        bf16_t* p = base + (size_t)(j0 + bj * 128) * ldj + s;
                        const unsigned w0 = cvt_pk_bf16(v0[0], v0[1]), w1 = cvt_pk_bf16(v0[2], v0[3]), w2 = cvt_pk_bf16(v1[0], v1[1]), w3 = cvt_pk_bf16(v1[2], v1[3]);
                        p[0] = (bf16_t)(w0 & 0xffff); p[ldj] = (bf16_t)(w0 >> 16); p[2 * ldj] = (bf16_t)(w1 & 0xffff); p[3 * ldj] = (bf16_t)(w1 >> 16);
                        p[4 * ldj] = (bf16_t)(w2 & 0xffff); p[5 * ldj] = (bf16_t)(w2 >> 16); p[6 * ldj] = (bf16_t)(w3 & 0xffff); p[7 * ldj] = (bf16_t)(w3 >> 16);
                    }
                }
            }
            return;
        }
        int kind; bf16_t* base; int ld; int coff;
        if (pn < 6) { kind = 1; base = ys; ld = YLD; coff = (pn - 4) * 256; }
        else if (pn < 8) { kind = 2; base = ys; ld = YLD; coff = 512 + (pn - 6) * 256; }
        else if (pn < 10) { kind = 2; base = vb; ld = 512; coff = (pn - 8) * 256; }
        else if (pn < 12) { kind = 1; base = bz; ld = 512; coff = (pn - 10) * 256; }
        else if (pn < 30) { kind = (pn < 24) ? 4 : 0; base = qkv; ld = 4608; coff = (pn - 12) * 256; }
        else { kind = 1; base = ys; ld = YLD; coff = 1024 + (pn - 30) * 256; }
        const bool do_rope = (kind == 4) && ((wc & 1) == 0);
        f32x4 wv[2][2];
        if (I8) {
#pragma unroll
            for (int bj = 0; bj < 2; ++bj) { const float* wp = wsi + pn * 256 + bj * 128 + cl0; wv[bj][0] = *(const f32x4*)wp; wv[bj][1] = *(const f32x4*)(wp + 4); }
        }
        f32x4 csn[4];
        if (do_rope) { const int pos = (row0 < TP) ? (row0 & 8191) : ((row0 - TP) & 2047); const f32x4* rp = (const f32x4*)(rope + (size_t)pos * 8);
#pragma unroll
            for (int i = 0; i < 4; ++i) csn[i] = rp[i]; }
#pragma unroll
        for (int ai = 0; ai < 2; ++ai) {
            float rsv[4];
            if (I8) {
#pragma unroll
                for (int g = 0; g < 4; ++g) rsv[g] = xsc[row0 + ai * 128 + g * 16];
            }
#pragma unroll
            for (int m = 0; m < 4; ++m) {
                const int row = row0 + ai * 128 + m * 16;
                bf16_t* rowp = base + (size_t)row * ld + coff + cl0;
                f32x2 cs[8];
                if (do_rope) {
#pragma unroll
                    for (int i = 0; i < 4; ++i) { const f32x4 t4 = csn[i];
                        cs[2 * i] = (f32x2){fq < 2 ? t4[0] : 1.0f, fq == 0 ? -t4[1] : (fq == 1 ? t4[1] : 0.0f)};
                        cs[2 * i + 1] = (f32x2){fq < 2 ? t4[2] : 1.0f, fq == 0 ? -t4[3] : (fq == 1 ? t4[3] : 0.0f)}; }
                    if (ai * 4 + m < 7) { const int g1 = ai * 4 + m + 1; const int rown = row0 + (g1 >> 2) * 128 + (g1 & 3) * 16;
                        const int posn = (rown < TP) ? (rown & 8191) : ((rown - TP) & 2047); const f32x4* rp = (const f32x4*)(rope + (size_t)posn * 8);
#pragma unroll
                        for (int i = 0; i < 4; ++i) csn[i] = rp[i]; }
                }
#pragma unroll
                for (int bj = 0; bj < 2; ++bj) {
                    float v[8];
                    if (I8) { const float rs = rsv[m];
                        const i32x4 i0 = __builtin_bit_cast(i32x4, acc[ai][bj][m][0]), i1 = __builtin_bit_cast(i32x4, acc[ai][bj][m][1]);
#pragma unroll
                        for (int i = 0; i < 4; ++i) { v[i] = (float)i0[i] * (rs * wv[bj][0][i]); v[4 + i] = (float)i1[i] * (rs * wv[bj][1][i]); }
                    } else {
#pragma unroll
                        for (int i = 0; i < 4; ++i) { v[i] = acc[ai][bj][m][0][i]; v[4 + i] = acc[ai][bj][m][1][i]; }
                    }
                    if (kind == 1) {
#pragma unroll
                        for (int i = 0; i < 8; ++i) v[i] = silu_f(v[i]);
                    } else if (kind == 2) {
#pragma unroll
                        for (int i = 0; i < 8; ++i) v[i] = gelu_f(v[i]);
                    } else if (do_rope) {
                        float o[8];
#pragma unroll
                        for (int i = 0; i < 8; ++i) o[i] = __shfl_xor(v[i], 16);
#pragma unroll
                        for (int i = 0; i < 8; ++i) v[i] = v[i] * cs[i][0] + o[i] * cs[i][1];
                    }
                    u32x4 w; w.x = cvt_pk_bf16(v[0], v[1]); w.y = cvt_pk_bf16(v[2], v[3]); w.z = cvt_pk_bf16(v[4], v[5]); w.w = cvt_pk_bf16(v[6], v[7]);
                    *(u32x4*)(rowp + bj * 128) = w;
                }
            }
        }
    }
};

struct EpiDft {
    static constexpr bool PERM = true;
    bf16_t* ys; const bf16_t* pqtp; const bf16_t* pqts; bool dry; const float* qsc;
    __device__ __forceinline__ void operator()(const f32x4 (&acc)[2][2][4][2], const Unit& u, int wr, int wc, int fr, int fq) const {
        const int S = u.aux ? SS : SP; const int tb = u.aux ? TP : 0;
        const float scale = u.aux ? 0.001953125f : 0.0009765625f;
        const int seq = u.pn >> 1; const int j0 = (u.pn & 1) * 256 + wc * 32 + 8 * fq;
        const int k0 = u.pm * 256 + wr * 64 + fr;
        const float sgn = (fr & 1) ? -1.0f : 1.0f;
        const bf16_t* prow = (u.aux ? pqts : pqtp) + (size_t)(seq * 512 + j0) * (2 * S) + S;
        float cor[2][8], dq[2][8];
#pragma unroll
        for (int bj = 0; bj < 2; ++bj)
#pragma unroll
            for (int i = 0; i < 8; ++i) { cor[bj][i] = sgn * bf1(prow[(size_t)(bj * 128 + i) * (2 * S)]); dq[bj][i] = qsc[(u.aux ? 2048 : 0) + seq * 512 + j0 + bj * 128 + i] * (1.0f / 127.0f); }
        u32x4 zn[2];
        { const bf16_t* rp0 = ys + (size_t)(tb + seq * S + k0) * YLD + j0; zn[0] = *(const u32x4*)rp0; zn[1] = *(const u32x4*)(rp0 + 128); }
#pragma unroll
        for (int g = 0; g < 8; ++g) {
            const int ai = g >> 2, m = g & 3;
            const int tok = tb + seq * S + k0 + ai * 128 + m * 16;
            bf16_t* rowp = ys + (size_t)tok * YLD + j0;
            const u32x4 zc[2] = {zn[0], zn[1]};
            if (g < 7) { const int g1 = g + 1; const bf16_t* rpn = ys + (size_t)(tb + seq * S + k0 + (g1 >> 2) * 128 + (g1 & 3) * 16) * YLD + j0;
                zn[0] = *(const u32x4*)rpn; zn[1] = *(const u32x4*)(rpn + 128); }
#pragma unroll
            for (int bj = 0; bj < 2; ++bj) {
                const u32x4 z = zc[bj];
                const i32x4 i0 = __builtin_bit_cast(i32x4, acc[ai][bj][m][0]), i1 = __builtin_bit_cast(i32x4, acc[ai][bj][m][1]);
                f32x4 a0, a1;
#pragma unroll
                for (int i = 0; i < 4; ++i) { a0[i] = (float)i0[i] * dq[bj][i]; a1[i] = (float)i1[i] * dq[bj][4 + i]; }
                u32x4 w;
                w.x = cvt_pk_bf16((a0[0] + cor[bj][0]) * scale * bf_lo(z.x), (a0[1] + cor[bj][1]) * scale * bf_hi(z.x));
                w.y = cvt_pk_bf16((a0[2] + cor[bj][2]) * scale * bf_lo(z.y), (a0[3] + cor[bj][3]) * scale * bf_hi(z.y));
                w.z = cvt_pk_bf16((a1[0] + cor[bj][4]) * scale * bf_lo(z.z), (a1[1] + cor[bj][5]) * scale * bf_hi(z.z));
                w.w = cvt_pk_bf16((a1[2] + cor[bj][6]) * scale * bf_lo(z.w), (a1[3] + cor[bj][7]) * scale * bf_hi(z.w));
                if (!dry) *(u32x4*)(rowp + bj * 128) = w;
            }
            asm volatile("" ::: "memory");
        }
    }
};

struct EpiGate {
    static constexpr bool PERM = true;
    u32x4* sg; const float* xsc; const float* wsc;
    __device__ __forceinline__ void operator()(f32x4 (&acc)[2][2][4][2], const Unit& u, int wr, int wc, int fr, int fq) const {
        const int k = u.aux & 255;
        const int tid = (wr * 4 + wc) * 64 + fq * 16 + fr;
        const int row0 = u.pm * 256 + wr * 64 + fr; const int c0 = u.pn * 256 + wc * 32 + 8 * fq;
        char* ga = (char*)sg + (size_t)k * 131072;
        f32x4 wv[2][2];
#pragma unroll
        for (int bj = 0; bj < 2; ++bj) { wv[bj][0] = *(const f32x4*)(wsc + k * 2048 + c0 + bj * 128); wv[bj][1] = *(const f32x4*)(wsc + k * 2048 + c0 + bj * 128 + 4); }
        float rsv[8];
#pragma unroll
        for (int g = 0; g < 8; ++g) rsv[g] = xsc[row0 + (g >> 2) * 128 + (g & 3) * 16];
#pragma unroll
        for (int g = 0; g < 8; ++g) {
            const int ai = g >> 2, m = g & 3;
            const float rs = rsv[g];
#pragma unroll
            for (int bj = 0; bj < 2; ++bj) {
                const i32x4 i0 = __builtin_bit_cast(i32x4, acc[ai][bj][m][0]), i1 = __builtin_bit_cast(i32x4, acc[ai][bj][m][1]);
                float s[8];
#pragma unroll
                for (int i = 0; i < 4; ++i) { s[i] = fmaxf(sigmoid_f((float)i0[i] * (rs * wv[bj][0][i])), 9.5367431640625e-07f); s[4 + i] = fmaxf(sigmoid_f((float)i1[i] * (rs * wv[bj][1][i])), 9.5367431640625e-07f); }
                u32x4 w; w.x = cvt_pk_bf16(s[0], s[1]); w.y = cvt_pk_bf16(s[2], s[3]); w.z = cvt_pk_bf16(s[4], s[5]); w.w = cvt_pk_bf16(s[6], s[7]);
                unsigned o = (unsigned)tid * 16u; asm volatile("" : "+v"(o));
                *(u32x4*)(ga + (size_t)(((ai * 4 + m) * 2 + bj) * 8192) + o) = w;
            }
            asm volatile("" ::: "memory");
        }
    }
};
struct EpiProj {
    static constexpr bool PERM = true;
    const u32x4* sg; bf16_t* merged;
    __device__ __forceinline__ void operator()(f32x4 (&acc)[2][2][4][2], const Unit& u, int wr, int wc, int fr, int fq) const {
        const int k = u.aux & 255;
        const int tid = (wr * 4 + wc) * 64 + fq * 16 + fr;
        const int row0 = u.pm * 256 + wr * 64 + fr; const int c0 = u.pn * 256 + wc * 32 + 8 * fq;
        const char* ga = (const char*)sg + (size_t)k * 131072; const char* gb = (const char*)sg + (size_t)(k < 2 ? k + 1 : k) * 131072;
        u32x4 zn, yn;
        { unsigned o = (unsigned)tid * 16u; asm volatile("" : "+v"(o)); zn = *(const u32x4*)(ga + o); yn = *(const u32x4*)(gb + o); }
#pragma unroll
        for (int idx = 0; idx < 16; ++idx) {
            const int ai = idx >> 3, m = (idx >> 1) & 3, bj = idx & 1;
            unsigned o = (unsigned)tid * 16u; asm volatile("" : "+v"(o));
            f32x4 v0 = acc[ai][bj][m][0], v1 = acc[ai][bj][m][1];
            const u32x4 z = zn, y = yn;
            if (idx < 15) { zn = *(const u32x4*)(ga + (size_t)((idx + 1) * 8192) + o); yn = *(const u32x4*)(gb + (size_t)((idx + 1) * 8192) + o); }
            float f[8] = {bf_lo(z.x), bf_hi(z.x), bf_lo(z.y), bf_hi(z.y), bf_lo(z.z), bf_hi(z.z), bf_lo(z.w), bf_hi(z.w)};
            if (k < 2) {
                const float d[8] = {bf_lo(y.x), bf_hi(y.x), bf_lo(y.y), bf_hi(y.y), bf_lo(y.z), bf_hi(y.z), bf_lo(y.w), bf_hi(y.w)};
#pragma unroll
                for (int i = 0; i < 8; ++i) f[i] *= __builtin_amdgcn_rcpf(d[i]);
            }
            v0[0] *= f[0]; v0[1] *= f[1]; v0[2] *= f[2]; v0[3] *= f[3]; v1[0] *= f[4]; v1[1] *= f[5]; v1[2] *= f[6]; v1[3] *= f[7];
            if (k == 2) { u32x4 w; w.x = cvt_pk_bf16(v0[0], v0[1]); w.y = cvt_pk_bf16(v0[2], v0[3]); w.z = cvt_pk_bf16(v1[0], v1[1]); w.w = cvt_pk_bf16(v1[2], v1[3]);
                *(u32x4*)(merged + (size_t)(row0 + ai * 128 + m * 16) * 2048 + c0 + bj * 128) = w; }
            acc[ai][bj][m][0] = v0; acc[ai][bj][m][1] = v1;
            asm volatile("" ::: "memory");
        }
    }
};

struct EpiOut {
    static constexpr bool PERM = false;
    const float* xp; const float* xs; float* out;
    __device__ __forceinline__ void operator()(const f32x4 (&acc)[2][2][4][2], const Unit& u, int wr, int wc, int fr, int fq) const {
        const int row0 = u.pm * 256 + wr * 64 + fr; const int c0 = u.pn * 256 + wc * 32 + 4 * fq;
        const float* xbase = (u.pm * 256 < TP) ? xp : (xs - (size_t)TP * 2048);
        f32x4 xn[4];
        { const float* xr = xbase + (size_t)row0 * 2048 + c0;
#pragma unroll
          for (int q = 0; q < 4; ++q) xn[q] = *(const f32x4*)(xr + (q >> 1) * 128 + (q & 1) * 16); }
#pragma unroll
        for (int g = 0; g < 8; ++g) {
            const int ai = g >> 2, m = g & 3;
            f32x4 xv[4];
#pragma unroll
            for (int q = 0; q < 4; ++q) xv[q] = xn[q];
            if (g < 7) { const int g1 = g + 1; const float* xr = xbase + (size_t)(row0 + (g1 >> 2) * 128 + (g1 & 3) * 16) * 2048 + c0;
#pragma unroll
                for (int q = 0; q < 4; ++q) xn[q] = *(const f32x4*)(xr + (q >> 1) * 128 + (q & 1) * 16); }
            float* orow = out + (size_t)(row0 + ai * 128 + m * 16) * 2048 + c0;
#pragma unroll
            for (int q = 0; q < 4; ++q) *(f32x4*)(orow + (q >> 1) * 128 + (q & 1) * 16) = xv[q] * ALPHA + acc[ai][q >> 1][m][q & 1];
            asm volatile("" ::: "memory");
        }
    }
};

struct SchedOutLn {
    const char* A; const char* B; int c;
    __device__ __forceinline__ bool next(int i, Unit& u) const {
        if (i >= 5) return false;
        const int x = c & 7, j = c >> 3; const int pm = i * 32 + x * 4 + (j >> 3), pn = j & 7;
        u.A = A + (size_t)pm * 256 * 2048 * 2; u.B = B + (size_t)pn * 256 * 2048 * 2; u.nt = 32; u.pm = pm; u.pn = pn; u.aux = 0; return true;
    }
};
struct EpiOutLn {
    static constexpr bool PERM = false;
    const float* xp; const float* xs; float* out; bf16_t* xb; const float* lg; const float* lb;
    unsigned long long* X; unsigned* cnt; LAS unsigned char* el; signed char* xb8; float* xsc; const float* gbmax;
    __device__ __forceinline__ void operator()(f32x4 (&acc)[2][2][4][2], const Unit& u, int wr, int wc, int fr, int fq) const {
        const int tid = (wr * 4 + wc) * 64 + fq * 16 + fr;
        const int rl0 = wr * 64 + fr; const int c0 = u.pn * 256 + wc * 32 + 4 * fq;
        const float* xbase = (u.pm * 256 < TP) ? xp : (xs - (size_t)TP * 2048);
        const int e0 = (u.pm * 256 + rl0) * 2048 + c0;
        LAS f32x2* P = (LAS f32x2*)el;
        LAS f32x2* St = (LAS f32x2*)(el + 8192);
        LAS float* Pm = (LAS float*)(el + 10240);
        LAS float* Sq = (LAS float*)(el + 14336);
        LAS float* Gs = (LAS float*)(el + 15616);
        if (tid < 128) { const int cg = (tid & 63) * 4; const f32x4 t4 = *(const f32x4*)((tid < 64 ? lg : lb) + u.pn * 256 + cg); *(LAS f32x4*)(Gs + (tid < 64 ? 0 : 256) + cg) = t4; }
        f32x4 xv[4];
        { int e = e0; asm volatile("" : "+v"(e));
#pragma unroll
          for (int q = 0; q < 4; ++q) xv[q] = *(const f32x4*)(xbase + e + (q >> 1) * 128 + (q & 1) * 16); }
#pragma unroll
        for (int g = 0; g < 8; ++g) {
            const int ai = g >> 2, m = g & 3;
            float s = 0.f, ss = 0.f, zm = 0.f;
#pragma unroll
            for (int q = 0; q < 4; ++q) { const f32x4 z = xv[q] * ALPHA + acc[ai][q >> 1][m][q & 1]; acc[ai][q >> 1][m][q & 1] = z;
                s += (z[0] + z[1]) + (z[2] + z[3]); ss += (z[0] * z[0] + z[1] * z[1]) + (z[2] * z[2] + z[3] * z[3]);
                zm = fmaxf(zm, fmaxf(fmaxf(fabsf(z[0]), fabsf(z[1])), fmaxf(fabsf(z[2]), fabsf(z[3])))); }
            if (g < 7) { int e = e0; asm volatile("" : "+v"(e)); const int g1 = g + 1;
#pragma unroll
                for (int q = 0; q < 4; ++q) xv[q] = *(const f32x4*)(xbase + e + ((g1 >> 2) * 128 + (g1 & 3) * 16) * 2048 + (q >> 1) * 128 + (q & 1) * 16); }
            s += __shfl_xor(s, 16); s += __shfl_xor(s, 32); ss += __shfl_xor(ss, 16); ss += __shfl_xor(ss, 32);
            zm = fmaxf(zm, __shfl_xor(zm, 16)); zm = fmaxf(zm, __shfl_xor(zm, 32));
            { int pi = rl0 * 4 + wc; asm volatile("" : "+v"(pi));
              if (fq == 0) { P[pi + (ai * 128 + m * 16) * 4] = (f32x2){s, ss}; Pm[pi + (ai * 128 + m * 16) * 4] = zm; } }
            asm volatile("" ::: "memory");
        }
        __syncthreads();
        unsigned long long* xrow = X + ((size_t)u.pm * 256 + (tid & 255)) * 16;
        if (tid < 256) {
            const f32x2 a = P[tid * 4 + 0], b = P[tid * 4 + 1], c2 = P[tid * 4 + 2], d = P[tid * 4 + 3];
            const float S = (a[0] + b[0]) + (c2[0] + d[0]), Q = (a[1] + b[1]) + (c2[1] + d[1]);
            const float M = fmaxf(fmaxf(Pm[tid * 4 + 0], Pm[tid * 4 + 1]), fmaxf(Pm[tid * 4 + 2], Pm[tid * 4 + 3]));
            __hip_atomic_store(xrow + 2 * u.pn, ((unsigned long long)__float_as_uint(Q) << 32) | __float_as_uint(S), __ATOMIC_RELAXED, __HIP_MEMORY_SCOPE_AGENT);
            __hip_atomic_store(xrow + 2 * u.pn + 1, (unsigned long long)__float_as_uint(M), __ATOMIC_RELAXED, __HIP_MEMORY_SCOPE_AGENT);
        }
        __syncthreads();
        if (tid == 0) {
            __hip_atomic_fetch_add(cnt + u.pm, 1u, __ATOMIC_RELAXED, __HIP_MEMORY_SCOPE_AGENT);
            while (__hip_atomic_load(cnt + u.pm, __ATOMIC_RELAXED, __HIP_MEMORY_SCOPE_AGENT) < 8u) __builtin_amdgcn_s_sleep(1);
            __builtin_amdgcn_fence(__ATOMIC_ACQUIRE, "agent");
        }
        __syncthreads();
        if (tid < 256) {
            float S = 0.f, Q = 0.f, M = 0.f;
#pragma unroll
            for (int t = 0; t < 8; ++t) { const unsigned long long w = __hip_atomic_load(xrow + 2 * t, __ATOMIC_RELAXED, __HIP_MEMORY_SCOPE_AGENT); S += __uint_as_float((unsigned)w); Q += __uint_as_float((unsigned)(w >> 32));
                M = fmaxf(M, __uint_as_float((unsigned)__hip_atomic_load(xrow + 2 * t + 1, __ATOMIC_RELAXED, __HIP_MEMORY_SCOPE_AGENT))); }
            const float mean = S * (1.0f / 2048.0f); const float var = fmaxf(Q * (1.0f / 2048.0f) - mean * mean, 0.f); const float rstd = rsqrtf(var + LN_EPS);
            St[tid] = (f32x2){mean, rstd};
            const float bound = fmaxf((M + fabsf(mean)) * rstd * gbmax[0] + gbmax[1], 1e-20f);
            Sq[tid] = 127.0f / bound;
            if (xb8 && u.pn == 0) xsc[u.pm * 256 + tid] = bound * (1.0f / 127.0f);
        }
        __syncthreads();
#pragma unroll
        for (int g = 0; g < 8; ++g) {
            const int ai = g >> 2, m = g & 3; const int rl = ai * 128 + rl0 + m * 16;
            const f32x2 st = St[rl];
            int e = e0; asm volatile("" : "+v"(e));
            e += (ai * 128 + m * 16) * 2048;
            int cc = wc * 32 + 4 * fq; asm volatile("" : "+v"(cc));
#pragma unroll
            for (int q = 0; q < 4; ++q) {
                const f32x4 gq = *(const LAS f32x4*)(Gs + cc + (q >> 1) * 128 + (q & 1) * 16), bq = *(const LAS f32x4*)(Gs + 256 + cc + (q >> 1) * 128 + (q & 1) * 16);
                const f32x4 y = (acc[ai][q >> 1][m][q & 1] - st[0]) * st[1] * gq + bq;
                *(f32x4*)(out + e + (q >> 1) * 128 + (q & 1) * 16) = y;
                if (xb8) {
                    const float qs = Sq[rl];
                    const int q0 = (int)rintf(y[0] * qs), q1 = (int)rintf(y[1] * qs), q2 = (int)rintf(y[2] * qs), q3 = (int)rintf(y[3] * qs);
                    int e8 = (u.pm * 256 + rl0) * X8P + c0; asm volatile("" : "+v"(e8));
                    *(unsigned*)(xb8 + e8 + (ai * 128 + m * 16) * X8P + (q >> 1) * 128 + (q & 1) * 16) = (unsigned)(q0 & 255) | ((unsigned)(q1 & 255) << 8) | ((unsigned)(q2 & 255) << 16) | ((unsigned)(q3 & 255) << 24); }
            }
            asm volatile("" ::: "memory");
        }
    }
};

__device__ __forceinline__ void transpose_tile(LAS float* buf, const float* src, int ld_src, bf16_t* dst, int ld_dst, int r0, int c0) {
    const int tid = tid_opaque();
#pragma unroll
    for (int i = 0; i < 2; ++i) { const int e = tid + 512 * i; const int r = e >> 4, c4 = (e & 15) * 4;
        const f32x4 v = *(const f32x4*)(src + (size_t)(r0 + r) * ld_src + c0 + c4);
        buf[r * 65 + c4] = v[0]; buf[r * 65 + c4 + 1] = v[1]; buf[r * 65 + c4 + 2] = v[2]; buf[r * 65 + c4 + 3] = v[3]; }
    __syncthreads();
    { const int c = tid >> 3, r8 = (tid & 7) * 8; float v[8];
#pragma unroll
      for (int j = 0; j < 8; ++j) v[j] = buf[(r8 + j) * 65 + c];
      u32x4 w; w.x = cvt_pk_bf16(v[0], v[1]); w.y = cvt_pk_bf16(v[2], v[3]); w.z = cvt_pk_bf16(v[4], v[5]); w.w = cvt_pk_bf16(v[6], v[7]);
      *(u32x4*)(dst + (size_t)(c0 + c) * ld_dst + r0 + r8) = w; }
    __syncthreads();
}

__device__ __forceinline__ void transpose_block(LAS float* buf, const float* src, int ld_src, bf16_t* dst, int ld_dst, int r0, int c0) {
    const int tid = tid_opaque();
#pragma unroll
    for (int i = 0; i < 8; ++i) { const int e = tid + 512 * i; const int r = e >> 6, c4 = (e & 63) * 4;
        const f32x4 v = *(const f32x4*)(src + (size_t)(r0 + r) * ld_src + c0 + c4);
        buf[r * 257 + c4] = v[0]; buf[r * 257 + c4 + 1] = v[1]; buf[r * 257 + c4 + 2] = v[2]; buf[r * 257 + c4 + 3] = v[3]; }
    __syncthreads();
#pragma unroll
    for (int i = 0; i < 4; ++i) { const int e = tid + 512 * i; const int c = e >> 3, r8 = (e & 7) * 8; float v[8];
#pragma unroll
      for (int j = 0; j < 8; ++j) v[j] = buf[(r8 + j) * 257 + c];
      u32x4 w; w.x = cvt_pk_bf16(v[0], v[1]); w.y = cvt_pk_bf16(v[2], v[3]); w.z = cvt_pk_bf16(v[4], v[5]); w.w = cvt_pk_bf16(v[6], v[7]);
      *(u32x4*)(dst + (size_t)(c0 + c) * ld_dst + r0 + r8) = w; }
    __syncthreads();
}

__device__ __forceinline__ void cols_i8_item(LAS unsigned char* lds, const float* src, signed char* dst, float* scales, int it) {
    LAS float* cm = (LAS float*)lds;
    const int tid = tid_opaque();
    const int cidx = tid & 63, dp = tid >> 6;
    const float* wsrc = src + it * 64 + cidx + (size_t)(dp * 256) * NIN;
    float m = 0.f;
    for (int d = 0; d < 256; d += 8) {
        float t[8];
#pragma unroll
        for (int j = 0; j < 8; ++j) t[j] = wsrc[(size_t)(d + j) * NIN];
#pragma unroll
        for (int j = 0; j < 8; ++j) m = fmaxf(m, fabsf(t[j]));
    }
    cm[dp * 64 + cidx] = m;
    __syncthreads();
    float cmax = 0.f;
#pragma unroll
    for (int p = 0; p < 8; ++p) cmax = fmaxf(cmax, cm[p * 64 + cidx]);
    cmax = fmaxf(cmax, 1e-30f); const float qs = 127.0f / cmax;
    if (dp == 0) scales[it * 64 + cidx] = cmax * (1.0f / 127.0f);
    signed char* drow = dst + (size_t)(it * 64 + cidx) * 4096 + dp * 256;
    for (int d = 0; d < 256; d += 8) {
        float t[8];
#pragma unroll
        for (int j = 0; j < 8; ++j) t[j] = wsrc[(size_t)(d + j) * NIN];
        int q[8];
#pragma unroll
        for (int j = 0; j < 8; ++j) q[j] = (int)rintf(t[j] * qs) & 255;
        u32x2 w; w.x = (unsigned)q[0] | ((unsigned)q[1] << 8) | ((unsigned)q[2] << 16) | ((unsigned)q[3] << 24); w.y = (unsigned)q[4] | ((unsigned)q[5] << 8) | ((unsigned)q[6] << 16) | ((unsigned)q[7] << 24);
        *(u32x2*)(drow + d) = w;
    }
    __syncthreads();
}

__device__ __forceinline__ void fold_i8_item(LAS unsigned char* lds, const float* w_in_l, const float* w_amap_l, signed char* win8, float* wsi, int it) {
    LAS float* tt = (LAS float*)lds;
    LAS float* Mx = (LAS float*)(lds + 1024);
    LAS float* rmx = (LAS float*)(lds + 1024 + 8192);
    const int tid = tid_opaque();
    const int pg = it >> 3, dd0 = (it & 7) * 16; const int part = pg >> 2, g = pg & 3;
    if (tid < 128) tt[tid] = part == 0 ? cospif((float)tid * (1.0f / 64.0f)) : sinpif((float)tid * (1.0f / 64.0f));
    __syncthreads();
    {
        const int cc = tid & 127, q = tid >> 7;
        float a4[4] = {0.f, 0.f, 0.f, 0.f};
        const float* wm = w_amap_l + (size_t)g * 128 * 128 + dd0 + q * 4;
        for (int cp = 0; cp < 128; ++cp) {
            const float t = tt[(cc * cp) & 127];
            const f32x4 w = *(const f32x4*)(wm + (size_t)cp * 128);
            a4[0] += t * w[0]; a4[1] += t * w[1]; a4[2] += t * w[2]; a4[3] += t * w[3];
        }
        *(LAS f32x4*)(Mx + cc * 16 + q * 4) = (f32x4){a4[0], a4[1], a4[2], a4[3]};
    }
    __syncthreads();
    float o[4][16];
#pragma unroll
    for (int r = 0; r < 4; ++r)
#pragma unroll
        for (int j = 0; j < 16; ++j) o[r][j] = 0.f;
    const float* wa = w_in_l + (size_t)(tid * 4) * NIN + g * 128;
    for (int c4 = 0; c4 < 128; c4 += 4) {
        f32x4 wr_[4];
#pragma unroll
        for (int r = 0; r < 4; ++r) wr_[r] = *(const f32x4*)(wa + (size_t)r * NIN + c4);
#pragma unroll
        for (int e = 0; e < 4; ++e) {
            const f32x4 m0 = *(const LAS f32x4*)(Mx + (c4 + e) * 16), m1 = *(const LAS f32x4*)(Mx + (c4 + e) * 16 + 4), m2 = *(const LAS f32x4*)(Mx + (c4 + e) * 16 + 8), m3 = *(const LAS f32x4*)(Mx + (c4 + e) * 16 + 12);
#pragma unroll
            for (int r = 0; r < 4; ++r) { const float w = wr_[r][e];
#pragma unroll
                for (int j = 0; j < 4; ++j) { o[r][j] += w * m0[j]; o[r][4 + j] += w * m1[j]; o[r][8 + j] += w * m2[j]; o[r][12 + j] += w * m3[j]; } }
        }
    }
    float mx[16];
#pragma unroll
    for (int j = 0; j < 16; ++j) { mx[j] = fmaxf(fmaxf(fabsf(o[0][j]), fabsf(o[1][j])), fmaxf(fabsf(o[2][j]), fabsf(o[3][j])));
#pragma unroll
        for (int s = 32; s >= 1; s >>= 1) mx[j] = fmaxf(mx[j], __shfl_xor(mx[j], s)); }
    if ((tid & 63) == 0) {
#pragma unroll
        for (int j = 0; j < 16; ++j) rmx[(tid >> 6) * 16 + j] = mx[j]; }
    __syncthreads();
#pragma unroll
    for (int j = 0; j < 16; ++j) {
        float m = 0.f;
#pragma unroll
        for (int w = 0; w < 8; ++w) m = fmaxf(m, rmx[w * 16 + j]);
        m = fmaxf(m, 1e-30f); const float qs = 127.0f / m;
        const int row = part * 512 + g * 128 + dd0 + j;
        if (tid == 0) wsi[row] = m * (1.0f / 127.0f);
        const int q0 = (int)rintf(o[0][j] * qs) & 255, q1 = (int)rintf(o[1][j] * qs) & 255, q2 = (int)rintf(o[2][j] * qs) & 255, q3 = (int)rintf(o[3][j] * qs) & 255;
        *(unsigned*)(win8 + (size_t)row * 4096 + tid * 4) = (unsigned)q0 | ((unsigned)q1 << 8) | ((unsigned)q2 << 16) | ((unsigned)q3 << 24);
    }
    __syncthreads();
}
__device__ __forceinline__ void prep_win8(LAS unsigned char* lds, const float* w_in_l, const float* w_amap_l, signed char* win8, float* wsi) {
    for (int it = blockIdx.x; it < 176; it += gridDim.x) {
        if (it < 64) fold_i8_item(lds, w_in_l, w_amap_l, win8, wsi, it);
        else cols_i8_item(lds, w_in_l + 512, win8 + (size_t)1024 * 4096, wsi + 1024, it - 64);
    }
}
__device__ __forceinline__ void prep_phase(LAS unsigned char* lds, const Args& a) {
    unsigned char* ws = a.ws;
    const int tid = tid_opaque();
    const float* xp = a.in[0]; const float* xs = a.in[1];
    {
        signed char* xb8 = (signed char*)(ws + WS_XB8); float* xsc = (float*)(ws + WS_XSC);
        const int lane = tid & 63, wv = tid >> 6;
        for (int row = blockIdx.x * 8 + wv; row < T; row += gridDim.x * 8) {
            const float* src = (row < TP) ? (xp + (size_t)row * 2048) : (xs + (size_t)(row - TP) * 2048);
            f32x4 v[8]; float mxv = 0.f;
#pragma unroll
            for (int i = 0; i < 8; ++i) { v[i] = *(const f32x4*)(src + i * 256 + lane * 4); mxv = fmaxf(mxv, fmaxf(fmaxf(fabsf(v[i][0]), fabsf(v[i][1])), fmaxf(fabsf(v[i][2]), fabsf(v[i][3])))); }
#pragma unroll
            for (int o = 32; o >= 1; o >>= 1) mxv = fmaxf(mxv, __shfl_xor(mxv, o));
            mxv = fmaxf(mxv, 1e-20f); const float qs = 127.0f / mxv;
            if (lane == 0) xsc[row] = mxv * (1.0f / 127.0f);
#pragma unroll
            for (int i = 0; i < 8; ++i) {
                const int c = i * 256 + lane * 4;
                const int q0 = (int)rintf(v[i][0] * qs), q1 = (int)rintf(v[i][1] * qs), q2 = (int)rintf(v[i][2] * qs), q3 = (int)rintf(v[i][3] * qs);
                *(unsigned*)(xb8 + (size_t)row * X8P + c) = (unsigned)(q0 & 255) | ((unsigned)(q1 & 255) << 8) | ((unsigned)(q2 & 255) << 16) | ((unsigned)(q3 & 255) << 24);
            }
        }
    }
    {
        float* gb = (float*)(ws + WS_CTL) + 512;
        if (blockIdx.x < 2) {
            const int l = blockIdx.x; float g = 0.f, b = 0.f;
            for (int i = tid; i < 2048; i += NTHREADS) { g = fmaxf(g, fabsf(a.in[10][l * 2048 + i])); b = fmaxf(b, fabsf(a.in[11][l * 2048 + i])); }
#pragma unroll
            for (int o = 32; o >= 1; o >>= 1) { g = fmaxf(g, __shfl_xor(g, o)); b = fmaxf(b, __shfl_xor(b, o)); }
            if ((tid & 63) == 0) { atomicMax((unsigned*)(gb + 2 * l), __float_as_uint(g)); atomicMax((unsigned*)(gb + 2 * l + 1), __float_as_uint(b)); }
        }
        for (int it = blockIdx.x; it < 368; it += gridDim.x) {
            if (it < 64) fold_i8_item(lds, a.in[2], a.in[3], (signed char*)(ws + WS_WIN8), (float*)(ws + WS_WSI), it);
            else if (it < 176) cols_i8_item(lds, a.in[2] + 512, (signed char*)(ws + WS_WIN8) + (size_t)1024 * 4096, (float*)(ws + WS_WSI) + 1024, it - 64);
            else { const int l = (it - 176) / 96; cols_i8_item(lds, a.in[2] + (size_t)l * 2048 * NIN + 7680, (signed char*)(ws + WS_WG8) + (size_t)l * 6144 * 4096, (float*)(ws + WS_WSC) + (size_t)l * 6144, (it - 176) % 96); }
        }
    }
    {
        f32x2* rope = (f32x2*)(ws + WS_ROPE);
        for (int idx = blockIdx.x * NTHREADS + tid; idx < 8192 * 8; idx += gridDim.x * NTHREADS) {
            const int pos = idx >> 3, i = idx & 7;
            const float inv = powf(500000.0f, -(float)i * 0.125f);
            const float ang = (float)pos * inv;
            rope[idx] = (f32x2){cosf(ang), sinf(ang)};
        }
    }
    {
        LAS float* ct = (LAS float*)lds;
        for (int m = tid; m < 8192; m += NTHREADS) ct[m] = cospif((float)m * (1.0f / 4096.0f));
        __syncthreads();
        signed char* dp = (signed char*)(ws + WS_DP); signed char* ds = (signed char*)(ws + WS_DS);
        for (int k = blockIdx.x; k < 8192; k += gridDim.x) {
            for (int ch = tid; ch < 1024; ch += NTHREADS) {
                const int col = ch * 8; const int sn = col >= 4096; const int s0 = col & 4095;
                int q[8];
#pragma unroll
                for (int j = 0; j < 8; ++j) { const int mm = (k * (s0 + j)) & 8191; const float v = sn ? -ct[(mm - 2048) & 8191] : ct[mm]; q[j] = (int)rintf(v * 127.0f) & 255; }
                u32x2 w; w.x = (unsigned)q[0] | ((unsigned)q[1] << 8) | ((unsigned)q[2] << 16) | ((unsigned)q[3] << 24); w.y = (unsigned)q[4] | ((unsigned)q[5] << 8) | ((unsigned)q[6] << 16) | ((unsigned)q[7] << 24);
                *(u32x2*)(dp + (size_t)k * 8192 + col) = w;
            }
        }
        for (int k = blockIdx.x; k < 2048; k += gridDim.x) {
            if (tid < 256) { const int col = tid * 8; const int sn = col >= 1024; const int s0 = col & 1023;
                int q[8];
#pragma unroll
                for (int j = 0; j < 8; ++j) { const int mm = (4 * k * (s0 + j)) & 8191; const float v = sn ? -ct[(mm - 2048) & 8191] : ct[mm]; q[j] = (int)rintf(v * 127.0f) & 255; }
                u32x2 w; w.x = (unsigned)q[0] | ((unsigned)q[1] << 8) | ((unsigned)q[2] << 16) | ((unsigned)q[3] << 24); w.y = (unsigned)q[4] | ((unsigned)q[5] << 8) | ((unsigned)q[6] << 16) | ((unsigned)q[7] << 24);
                *(u32x2*)(ds + (size_t)k * 2048 + col) = w; }
        }
        __syncthreads();
    }
    {
        LAS float* buf = (LAS float*)lds;
        const float* wbr = a.in[8]; const float* wo = a.in[9];
        bf16_t* wb = (bf16_t*)(ws + WS_WB); bf16_t* wout = (bf16_t*)(ws + WS_WOUT);
        for (int it = blockIdx.x; it < 6 * 8 * 8; it += gridDim.x) {
            const int lk = it / 64, r = it % 64; const int tr = r & 7, tc = r >> 3;
            transpose_block(buf, wbr + (size_t)lk * 512 * 2048, 2048, wb + (size_t)lk * 2048 * 2048, 2048, tr * 64, tc * 256);
        }
        for (int it = blockIdx.x; it < 2 * 32 * 8; it += gridDim.x) {
            const int l = it / 256, r = it % 256; const int tr = r & 31, tc = r >> 5;
            transpose_block(buf, wo + (size_t)l * 2048 * 2048, 2048, wout + (size_t)l * 2048 * 2048, 2048, tr * 64, tc * 256);
        }
    }
}

__device__ __forceinline__ void pq_fold_row(bf16_t* R, int S, signed char* q8, float* qscale, int lane) {
    const int H = S >> 1; const int nch = H >> 3;
    float mx = 0.f;
    for (int cb = lane; cb < nch; cb += 256) {
        u32x4 pv[4], qv[4], pav[4], qav[4]; unsigned pbv[4], qbv[4];
#pragma unroll
        for (int j = 0; j < 4; ++j) { const int c = cb + 64 * j;
            if (c < nch) { pv[j] = *(const u32x4*)(R + 8 * c); qv[j] = *(const u32x4*)(R + H + 8 * c);
                pav[j] = *(const u32x4*)(R + S + (H - 8 * c - 8)); qav[j] = *(const u32x4*)(R + S + H + (H - 8 * c - 8));
                pbv[j] = 0u; qbv[j] = 0u;
                if (c > 0) { pbv[j] = *(const unsigned short*)(R + S + (H - 8 * c)); qbv[j] = *(const unsigned short*)(R + S + H + (H - 8 * c)); } } }
#pragma unroll
        for (int j = 0; j < 4; ++j) { const int c = cb + 64 * j;
            if (c < nch) {
                const u32x4 p = pv[j], q = qv[j], pa = pav[j], qa = qav[j]; const unsigned pb0 = pbv[j], qb0 = qbv[j];
                const float pf[8] = {bf_lo(p.x), bf_hi(p.x), bf_lo(p.y), bf_hi(p.y), bf_lo(p.z), bf_hi(p.z), bf_lo(p.w), bf_hi(p.w)};
                const float qf[8] = {bf_lo(q.x), bf_hi(q.x), bf_lo(q.y), bf_hi(q.y), bf_lo(q.z), bf_hi(q.z), bf_lo(q.w), bf_hi(q.w)};
                const float paf[8] = {bf_lo(pa.x), bf_hi(pa.x), bf_lo(pa.y), bf_hi(pa.y), bf_lo(pa.z), bf_hi(pa.z), bf_lo(pa.w), bf_hi(pa.w)};
                const float qaf[8] = {bf_lo(qa.x), bf_hi(qa.x), bf_lo(qa.y), bf_hi(qa.y), bf_lo(qa.z), bf_hi(qa.z), bf_lo(qa.w), bf_hi(qa.w)};
                float pe[8], qo[8];
                pe[0] = pf[0] + __uint_as_float(pb0 << 16); qo[0] = (c > 0) ? (qf[0] - __uint_as_float(qb0 << 16)) : 0.f;
#pragma unroll
                for (int e = 1; e < 8; ++e) { pe[e] = pf[e] + paf[8 - e]; qo[e] = qf[e] - qaf[8 - e]; }
#pragma unroll
                for (int e = 0; e < 8; ++e) mx = fmaxf(mx, fmaxf(fabsf(pe[e]), fabsf(qo[e])));
                u32x4 w; w.x = cvt_pk_bf16(pe[0], pe[1]); w.y = cvt_pk_bf16(pe[2], pe[3]); w.z = cvt_pk_bf16(pe[4], pe[5]); w.w = cvt_pk_bf16(pe[6], pe[7]);
                *(u32x4*)(R + 8 * c) = w;
                w.x = cvt_pk_bf16(qo[0], qo[1]); w.y = cvt_pk_bf16(qo[2], qo[3]); w.z = cvt_pk_bf16(qo[4], qo[5]); w.w = cvt_pk_bf16(qo[6], qo[7]);
                *(u32x4*)(R + H + 8 * c) = w;
            } }
    }
#pragma unroll
    for (int o = 32; o >= 1; o >>= 1) mx = fmaxf(mx, __shfl_xor(mx, o));
    mx = fmaxf(mx, 1e-30f); const float qs = 127.0f / mx;
    if (lane == 0) *qscale = mx * (1.0f / 127.0f);
    for (int c = lane; c < nch; c += 64) {
        const u32x4 p = *(const u32x4*)(R + 8 * c), q = *(const u32x4*)(R + H + 8 * c);
        const float pf[8] = {bf_lo(p.x), bf_hi(p.x), bf_lo(p.y), bf_hi(p.y), bf_lo(p.z), bf_hi(p.z), bf_lo(p.w), bf_hi(p.w)};
        const float qf[8] = {bf_lo(q.x), bf_hi(q.x), bf_lo(q.y), bf_hi(q.y), bf_lo(q.z), bf_hi(q.z), bf_lo(q.w), bf_hi(q.w)};
        int a8[8], b8[8];
#pragma unroll
        for (int e = 0; e < 8; ++e) { a8[e] = (int)rintf(pf[e] * qs) & 255; b8[e] = (int)rintf(qf[e] * qs) & 255; }
        u32x2 w; w.x = (unsigned)a8[0] | ((unsigned)a8[1] << 8) | ((unsigned)a8[2] << 16) | ((unsigned)a8[3] << 24); w.y = (unsigned)a8[4] | ((unsigned)a8[5] << 8) | ((unsigned)a8[6] << 16) | ((unsigned)a8[7] << 24);
        *(u32x2*)(q8 + 8 * c) = w;
        w.x = (unsigned)b8[0] | ((unsigned)b8[1] << 8) | ((unsigned)b8[2] << 16) | ((unsigned)b8[3] << 24); w.y = (unsigned)b8[4] | ((unsigned)b8[5] << 8) | ((unsigned)b8[6] << 16) | ((unsigned)b8[7] << 24);
        *(u32x2*)(q8 + H + 8 * c) = w;
    }
}

__device__ __forceinline__ void sgu_item(LAS unsigned char* lds, bf16_t* ys, const bf16_t* vb, const bf16_t* bz, const float* sw, const float* sb, const float* lg, const float* lb, int item, bool dry) {
    const int tid = tid_opaque(), lane = tid & 63, wid = tid >> 6;
    const int cidx = item >> 2, g = item & 3; const int t0 = cidx * 128;
    LAS bf16_t* vT = (LAS bf16_t*)lds;
    {
        const int q = tid >> 2, part = tid & 3;
        const bf16_t* vrow = vb + (size_t)(t0 + q) * 512;
        float s = 0.f, ss = 0.f;
#pragma unroll
        for (int i = 0; i < 16; ++i) {
            const u32x4 z = *(const u32x4*)(vrow + part * 128 + i * 8);
            const float f0 = bf_lo(z.x), f1 = bf_hi(z.x), f2 = bf_lo(z.y), f3 = bf_hi(z.y), f4 = bf_lo(z.z), f5 = bf_hi(z.z), f6 = bf_lo(z.w), f7 = bf_hi(z.w);
            s += ((f0 + f1) + (f2 + f3)) + ((f4 + f5) + (f6 + f7));
            ss += ((f0 * f0 + f1 * f1) + (f2 * f2 + f3 * f3)) + ((f4 * f4 + f5 * f5) + (f6 * f6 + f7 * f7));
        }
        s += __shfl_xor(s, 1); s += __shfl_xor(s, 2); ss += __shfl_xor(ss, 1); ss += __shfl_xor(ss, 2);
        const float mean = s * (1.0f / 512.0f); const float var = fmaxf(ss * (1.0f / 512.0f) - mean * mean, 0.f); const float rstd = rsqrtf(var + LN_EPS);
#pragma unroll
        for (int i = 0; i < 4; ++i) {
            const int c = part * 32 + i * 8;
            const u32x4 z = *(const u32x4*)(vrow + g * 128 + c);
            float f[8] = {bf_lo(z.x), bf_hi(z.x), bf_lo(z.y), bf_hi(z.y), bf_lo(z.z), bf_hi(z.z), bf_lo(z.w), bf_hi(z.w)};
#pragma unroll
            for (int e = 0; e < 8; e += 2) {
                const float y0 = (f[e] - mean) * rstd * lg[g * 128 + c + e] + lb[g * 128 + c + e];
                const float y1 = (f[e + 1] - mean) * rstd * lg[g * 128 + c + e + 1] + lb[g * 128 + c + e + 1];
                const unsigned w = cvt_pk_bf16(y0, y1);
                vT[(c + e) * 136 + q] = (bf16_t)(w & 0xffff); vT[(c + e + 1) * 136 + q] = (bf16_t)(w >> 16);
            }
        }
    }
    __syncthreads();
    {
        const int fr = lane & 15, quad = lane >> 4; const int p = wid * 16 + fr;
        bf16x8 bw[4];
        const float* wrow = sw + ((size_t)g * 128 + p) * 128;
#pragma unroll
        for (int ks = 0; ks < 4; ++ks) {
            const f32x4 a0 = *(const f32x4*)(wrow + ks * 32 + quad * 8), a1 = *(const f32x4*)(wrow + ks * 32 + quad * 8 + 4);
            u32x4 w; w.x = cvt_pk_bf16(a0[0], a0[1]); w.y = cvt_pk_bf16(a0[2], a0[3]); w.z = cvt_pk_bf16(a1[0], a1[1]); w.w = cvt_pk_bf16(a1[2], a1[3]);
            bw[ks] = __builtin_bit_cast(bf16x8, w);
        }
        const float bias = sb[g * 128 + p];
        const int t = t0 + p;
#pragma unroll
        for (int mt = 0; mt < 8; ++mt) {
            f32x4 acc = (f32x4){0.f, 0.f, 0.f, 0.f};
#pragma unroll
            for (int ks = 0; ks < 4; ++ks) {
                const bf16x8 av = *(const LAS bf16x8*)(vT + (16 * mt + fr) * 136 + ks * 32 + quad * 8);
                acc = __builtin_amdgcn_mfma_f32_16x16x32_bf16(av, bw[ks], acc, 0, 0, 0);
            }
            const int c4 = g * 128 + 16 * mt + 4 * quad;
            bf16_t* up = ys + (size_t)t * YLD + 512 + c4;
            const u32x2 uz = *(const u32x2*)up; const u32x2 zz = *(const u32x2*)(bz + (size_t)t * 512 + c4);
            u32x2 w;
            w.x = cvt_pk_bf16(bf_lo(uz.x) * (acc[0] + bias) * bf_lo(zz.x), bf_hi(uz.x) * (acc[1] + bias) * bf_hi(zz.x));
            w.y = cvt_pk_bf16(bf_lo(uz.y) * (acc[2] + bias) * bf_lo(zz.y), bf_hi(uz.y) * (acc[3] + bias) * bf_hi(zz.y));
            if (!dry) *(u32x2*)up = w;
        }
    }
    __syncthreads();
}

struct AttnGeo { int tbase, dil, L, r, m0, gh; };
__device__ __forceinline__ AttnGeo attn_decode(int item) {
    AttnGeo g; g.gh = item % 24; const int ua = item / 24; const int grp = g.gh >> 3;
    int S, u;
    if (ua < 256) { const int sq = ua >> 6; u = ua & 63; S = SP; g.tbase = sq * SP; }
    else { const int v = ua - 256; const int sq = v >> 4; u = v & 15; S = SS; g.tbase = TP + sq * SS; }
    const int dsh = 2 * grp; g.dil = 1 << dsh; g.L = S >> dsh;
    g.r = u & (g.dil - 1); g.m0 = (u >> dsh) * 128;
    return g;
}
__device__ __forceinline__ void attn_phase(LAS unsigned char* lds, bf16_t* qkv, float* lse, int first, int count, int stride, bool dry) {
    const int tid = tid_opaque(), lane = tid & 63, wid = tid >> 6, fr = lane & 15, quad = lane >> 4;
    constexpr int KST = 72;
    LAS bf16_t* Ks = (LAS bf16_t*)lds;
    LAS bf16_t* Vs = (LAS bf16_t*)(lds + 272 * KST * 2);
    u32x4 kz[4], vz[4]; bf16x8 bq[2];
#define ATT_LOAD(item_) do { const AttnGeo g_ = attn_decode(item_); \
        _Pragma("unroll") for (int i = 0; i < 4; ++i) { const int e = tid + 512 * i; const int key = e >> 3, dch = e & 7; const int mk = g_.m0 - 64 + key; const bool ok = (mk >= 0) && (mk < g_.L); \
            kz[i] = (u32x4){0u, 0u, 0u, 0u}; vz[i] = (u32x4){0u, 0u, 0u, 0u}; \
            if (ok) { const bf16_t* rowp = qkv + (size_t)(g_.tbase + mk * g_.dil + g_.r) * 4608 + g_.gh * 64 + dch * 8; kz[i] = *(const u32x4*)(rowp + 1536); vz[i] = *(const u32x4*)(rowp + 3072); } } \
        { const bf16_t* qrow_ = qkv + (size_t)(g_.tbase + (g_.m0 + 16 * wid + fr) * g_.dil + g_.r) * 4608 + g_.gh * 64; \
          bq[0] = *(const bf16x8*)(qrow_ + quad * 8); bq[1] = *(const bf16x8*)(qrow_ + 32 + quad * 8); } } while (0)
    if (count <= 0) return;
    ATT_LOAD(first);
    for (int n = 0; n < count; ++n) {
        const int item = first + n * stride;
        const AttnGeo g = attn_decode(item);
        __syncthreads();
#pragma unroll
        for (int i = 0; i < 4; ++i) { const int e = tid + 512 * i; const int key = e >> 3, dch = e & 7;
            *(LAS u32x4*)(Ks + key * KST + dch * 8) = kz[i]; *(LAS u32x4*)(Vs + key * KST + dch * 8) = vz[i]; }
        if (tid < 128) { const int key = 256 + (tid >> 3), dch = tid & 7;
            *(LAS u32x4*)(Ks + key * KST + dch * 8) = (u32x4){0u, 0u, 0u, 0u}; *(LAS u32x4*)(Vs + key * KST + dch * 8) = (u32x4){0u, 0u, 0u, 0u}; }
        const bf16x8 q0 = bq[0], q1 = bq[1];
        __syncthreads();
        if (n + 1 < count) ATT_LOAD(item + stride);
        const int ql = 16 * wid + fr; const int mq = g.m0 + ql;
        float sc[10][4];
        float mx = -3.0e38f;
        const int klo = max(ql, 64 - g.m0), khi = min(ql + 128, g.L + 63 - g.m0);
        const int kbase = 16 * wid + 4 * quad - klo; const unsigned krng = (unsigned)(khi - klo);
#pragma unroll
        for (int ti = 0; ti < 10; ++ti) {
            const int kk0 = 16 * (wid + ti);
            f32x4 acc = (f32x4){0.f, 0.f, 0.f, 0.f};
            const bf16x8 ka0 = *(const LAS bf16x8*)(Ks + (kk0 + fr) * KST + quad * 8), ka1 = *(const LAS bf16x8*)(Ks + (kk0 + fr) * KST + 32 + quad * 8);
            acc = __builtin_amdgcn_mfma_f32_16x16x32_bf16(ka0, q0, acc, 0, 0, 0);
            acc = __builtin_amdgcn_mfma_f32_16x16x32_bf16(ka1, q1, acc, 0, 0, 0);
#pragma unroll
            for (int j = 0; j < 4; ++j) {
                const bool ok = (unsigned)(kbase + 16 * ti + j) <= krng;
                const float sv = ok ? acc[j] * 0.125f : -1.0e30f;
                sc[ti][j] = sv; mx = fmaxf(mx, sv);
            }
        }
        mx = fmaxf(mx, __shfl_xor(mx, 16)); mx = fmaxf(mx, __shfl_xor(mx, 32));
        float sum = 0.f;
#pragma unroll
        for (int ti = 0; ti < 10; ++ti)
#pragma unroll
            for (int j = 0; j < 4; ++j) { const float p = __builtin_amdgcn_exp2f((sc[ti][j] - mx) * 1.4426950408889634f); sc[ti][j] = p; sum += p; }
        sum += __shfl_xor(sum, 16); sum += __shfl_xor(sum, 32);
        bf16x8 pb[5];
#pragma unroll
        for (int k2 = 0; k2 < 5; ++k2) {
            u32x4 w; w.x = cvt_pk_bf16(sc[2 * k2][0], sc[2 * k2][1]); w.y = cvt_pk_bf16(sc[2 * k2][2], sc[2 * k2][3]);
            w.z = cvt_pk_bf16(sc[2 * k2 + 1][0], sc[2 * k2 + 1][1]); w.w = cvt_pk_bf16(sc[2 * k2 + 1][2], sc[2 * k2 + 1][3]);
            pb[k2] = __builtin_bit_cast(bf16x8, w);
        }
        const float inv = 1.0f / sum;
        bf16_t* qrow = qkv + (size_t)(g.tbase + mq * g.dil + g.r) * 4608 + g.gh * 64;
        const unsigned vbase = (unsigned)(size_t)Vs + (unsigned)(((16 * wid + 4 * quad + (fr >> 2)) * KST + 4 * (fr & 3)) * 2);
#pragma unroll
        for (int mt = 0; mt < 4; ++mt) {
            u32x2 t0, t1, t2, t3, t4, t5, t6, t7, t8, t9;
            const unsigned va = vbase + mt * 32;
            asm volatile("ds_read_b64_tr_b16 %0, %10\n\tds_read_b64_tr_b16 %1, %10 offset:2304\n\tds_read_b64_tr_b16 %2, %10 offset:4608\n\tds_read_b64_tr_b16 %3, %10 offset:6912\n\t"
                         "ds_read_b64_tr_b16 %4, %10 offset:9216\n\tds_read_b64_tr_b16 %5, %10 offset:11520\n\tds_read_b64_tr_b16 %6, %10 offset:13824\n\tds_read_b64_tr_b16 %7, %10 offset:16128\n\t"
                         "ds_read_b64_tr_b16 %8, %10 offset:18432\n\tds_read_b64_tr_b16 %9, %10 offset:20736\n\ts_waitcnt lgkmcnt(0)"
                         : "=&v"(t0), "=&v"(t1), "=&v"(t2), "=&v"(t3), "=&v"(t4), "=&v"(t5), "=&v"(t6), "=&v"(t7), "=&v"(t8), "=&v"(t9) : "v"(va) : "memory");
            f32x4 o = (f32x4){0.f, 0.f, 0.f, 0.f};
            o = __builtin_amdgcn_mfma_f32_16x16x32_bf16(__builtin_bit_cast(bf16x8, ((u32x4){t0.x, t0.y, t1.x, t1.y})), pb[0], o, 0, 0, 0);
            o = __builtin_amdgcn_mfma_f32_16x16x32_bf16(__builtin_bit_cast(bf16x8, ((u32x4){t2.x, t2.y, t3.x, t3.y})), pb[1], o, 0, 0, 0);
            o = __builtin_amdgcn_mfma_f32_16x16x32_bf16(__builtin_bit_cast(bf16x8, ((u32x4){t4.x, t4.y, t5.x, t5.y})), pb[2], o, 0, 0, 0);
            o = __builtin_amdgcn_mfma_f32_16x16x32_bf16(__builtin_bit_cast(bf16x8, ((u32x4){t6.x, t6.y, t7.x, t7.y})), pb[3], o, 0, 0, 0);
            o = __builtin_amdgcn_mfma_f32_16x16x32_bf16(__builtin_bit_cast(bf16x8, ((u32x4){t8.x, t8.y, t9.x, t9.y})), pb[4], o, 0, 0, 0);
            u32x2 w; w.x = cvt_pk_bf16(o[0] * inv, o[1] * inv); w.y = cvt_pk_bf16(o[2] * inv, o[3] * inv);
            if (!dry) *(u32x2*)(qrow + 16 * mt + 4 * quad) = w;
        }
        if (quad == 0 && !dry) lse[(size_t)(g.tbase + mq * g.dil + g.r) * 24 + g.gh] = mx + __logf(sum);
    }
#undef ATT_LOAD
    __syncthreads();
}

__device__ __forceinline__ void combine_phase(bf16_t* ys, const bf16_t* qkv, const float* lse, bool dry) {
    const size_t n = (size_t)T * 64;
    const int tid = tid_opaque();
    for (size_t id = (size_t)blockIdx.x * NTHREADS + tid; id < n; id += (size_t)gridDim.x * NTHREADS) {
        const int t = (int)(id >> 6), h = (int)(id >> 3) & 7, ch = (int)id & 7;
        const float l0 = lse[(size_t)t * 24 + h], l1 = lse[(size_t)t * 24 + 8 + h], l2 = lse[(size_t)t * 24 + 16 + h];
        const float mx = fmaxf(l0, fmaxf(l1, l2));
        float w0 = __expf(l0 - mx), w1 = __expf(l1 - mx), w2 = __expf(l2 - mx);
        const float inv = 1.0f / (w0 + w1 + w2); w0 *= inv; w1 *= inv; w2 *= inv;
        const bf16_t* qr = qkv + (size_t)t * 4608 + h * 64 + ch * 8;
        const u32x4 o0 = *(const u32x4*)qr, o1 = *(const u32x4*)(qr + 512), o2 = *(const u32x4*)(qr + 1024);
        bf16_t* yp = ys + (size_t)t * YLD + 1024 + h * 64 + ch * 8;
        const u32x4 z = *(const u32x4*)yp;
        u32x4 w;
        w.x = cvt_pk_bf16((w0 * bf_lo(o0.x) + w1 * bf_lo(o1.x) + w2 * bf_lo(o2.x)) * bf_lo(z.x), (w0 * bf_hi(o0.x) + w1 * bf_hi(o1.x) + w2 * bf_hi(o2.x)) * bf_hi(z.x));
        w.y = cvt_pk_bf16((w0 * bf_lo(o0.y) + w1 * bf_lo(o1.y) + w2 * bf_lo(o2.y)) * bf_lo(z.y), (w0 * bf_hi(o0.y) + w1 * bf_hi(o1.y) + w2 * bf_hi(o2.y)) * bf_hi(z.y));
        w.z = cvt_pk_bf16((w0 * bf_lo(o0.z) + w1 * bf_lo(o1.z) + w2 * bf_lo(o2.z)) * bf_lo(z.z), (w0 * bf_hi(o0.z) + w1 * bf_hi(o1.z) + w2 * bf_hi(o2.z)) * bf_hi(z.z));
        w.w = cvt_pk_bf16((w0 * bf_lo(o0.w) + w1 * bf_lo(o1.w) + w2 * bf_lo(o2.w)) * bf_lo(z.w), (w0 * bf_hi(o0.w) + w1 * bf_hi(o1.w) + w2 * bf_hi(o2.w)) * bf_hi(z.w));
        if (!dry) *(u32x4*)yp = w;
    }
}

__device__ __forceinline__ void ln_phase(float* out, bf16_t* xb, const float* lg, const float* lb, bool write_bf, bool dry) {
    const int tid = tid_opaque(); const int lane = tid & 63, wid = tid >> 6;
    for (int row = blockIdx.x * 8 + wid; row < T; row += gridDim.x * 8) {
        float* rp = out + (size_t)row * 2048;
        f32x4 v[8]; float s = 0.f;
#pragma unroll
        for (int i = 0; i < 8; ++i) { v[i] = *(const f32x4*)(rp + i * 256 + lane * 4); s += (v[i][0] + v[i][1]) + (v[i][2] + v[i][3]); }
#pragma unroll
        for (int o = 32; o >= 1; o >>= 1) s += __shfl_xor(s, o);
        const float mean = s * (1.0f / 2048.0f); float q = 0.f;
#pragma unroll
        for (int i = 0; i < 8; ++i) { const f32x4 d = v[i] - mean; q += (d[0] * d[0] + d[1] * d[1]) + (d[2] * d[2] + d[3] * d[3]); }
#pragma unroll
        for (int o = 32; o >= 1; o >>= 1) q += __shfl_xor(q, o);
        const float rstd = rsqrtf(q * (1.0f / 2048.0f) + LN_EPS);
#pragma unroll
        for (int i = 0; i < 8; ++i) {
            const int c = i * 256 + lane * 4;
            const f32x4 gg = *(const f32x4*)(lg + c), bb = *(const f32x4*)(lb + c);
            const f32x4 y = (v[i] - mean) * rstd * gg + bb;
            if (!dry) *(f32x4*)(rp + c) = y;
            if (write_bf && !dry) { u32x2 w; w.x = cvt_pk_bf16(y[0], y[1]); w.y = cvt_pk_bf16(y[2], y[3]); *(u32x2*)(xb + (size_t)row * 2048 + c) = w; }
        }
    }
}

__global__ void __launch_bounds__(NTHREADS) fwd_kernel(Args a) {
    extern __shared__ __attribute__((aligned(16))) unsigned char lds_raw[];
    LAS unsigned char* lds = (LAS unsigned char*)lds_raw;
    unsigned char* ws = a.ws;
    const int G = gridDim.x, c_blk = blockIdx.x;
    const int lo = a.ph_lo, hi = a.ph_hi;
#ifndef P2SUB
#define P2SUB 0xf
#endif
#ifndef PMASK
#define PMASK 0xff
#endif
#if SINGLE_LAUNCH
#define IN(k) (true)
#else
#define IN(k) (lo <= (k) && (k) < hi)
#endif
#define SEAM(k) do { if (IN(k) && IN((k) + 1)) { if (a.ph_lo == 0x7fffff01) cg::this_grid().sync();   ++nbar; grid_bar(ctl, nbar * (unsigned)G); } } while (0)
    unsigned nbar = 0;
    bf16_t* xb = (bf16_t*)(ws + WS_XB); bf16_t* win = (bf16_t*)(ws + WS_WIN);
    bf16_t* ys = (bf16_t*)(ws + WS_YS); bf16_t* vb = (bf16_t*)(ws + WS_VB); bf16_t* bzb = (bf16_t*)(ws + WS_BZ);
    bf16_t* qkv = (bf16_t*)(ws + WS_QKV); float* lse = (float*)(ws + WS_LSE);
    bf16_t* merged = (bf16_t*)(ws + WS_MERGED);
    unsigned* ctl = (unsigned*)(ws + WS_CTL);
    LAS int* qslot = (LAS int*)(lds + 128 * 1024);

    if (IN(0) && (PMASK & 1)) { prep_phase(lds, a); }
    SEAM(0);
#pragma nounroll
    for (int l = 0; l < 2; ++l) {
        const int pb = 1 + 6 * l;
        int c = c_blk; asm volatile("" : "+s"(c));
        if (IN(pb) && (PMASK & 2)) {
            { SchedIn8 S{(const char*)(ws + WS_XB8), (const char*)(ws + WS_WIN8), G, c};
              EpiIn<true> E{ys, vb, bzb, qkv, (bf16_t*)(ws + WS_PQTP), (bf16_t*)(ws + WS_PQTS), (const f32x2*)(ws + WS_ROPE), (const float*)(ws + WS_XSC), (const float*)(ws + WS_WSI)};
              pg8::gemm_phase<EpiIn<true>, SchedIn8, true>(lds, X8P / 2, 2048, S, E); }
        }
        SEAM(pb);
        if (IN(pb + 1)) {
            const int tidf = tid_opaque(); const int lane = tidf & 63;
            for (int row = c * 8 + (tidf >> 6); row < 2048; row += G * 8) {
                pq_fold_row((bf16_t*)(ws + WS_PQTP) + (size_t)row * 16384, SP, (signed char*)(ws + WS_PQ8P) + (size_t)row * 8192, (float*)(ws + WS_QSC) + row, lane);
                pq_fold_row((bf16_t*)(ws + WS_PQTS) + (size_t)row * 4096, SS, (signed char*)(ws + WS_PQ8S) + (size_t)row * 2048, (float*)(ws + WS_QSC) + 2048 + row, lane);
            }
        }
        SEAM(pb + 1);
        if (IN(pb + 2) && (PMASK & 4)) {
            {
            const bool dry = false;
            EpiDft E{ys, (const bf16_t*)(ws + WS_PQTP), (const bf16_t*)(ws + WS_PQTS), dry, (const float*)(ws + WS_QSC)};
            if (P2SUB & 1) { SchedDftP S{(const char*)(ws + WS_DP), (const char*)(ws + WS_PQ8P), G, c}; pg8::gemm_phase<EpiDft, SchedDftP, true>(lds, 4096, 4096, S, E); }
            if (P2SUB & 2) { SchedDftS S{(const char*)(ws + WS_DS), (const char*)(ws + WS_PQ8S), G, c}; pg8::gemm_phase<EpiDft, SchedDftS, true>(lds, 1024, 1024, S, E); }
            const float* sw = a.in[6] + (size_t)l * 4 * 128 * 128; const float* sb = a.in[7] + (size_t)l * 4 * 128;
            const float* slg = a.in[4] + (size_t)l * 512; const float* slb = a.in[5] + (size_t)l * 512;
            constexpr int N_SGU = (T / 128) * 4, N_ATT = (T / 128) * 24;
            if (P2SUB & 4) for (int item = c; item < N_SGU; item += G) sgu_item(lds, ys, vb, bzb, sw, sb, slg, slb, item, dry);
            if (P2SUB & 8) {
                if (G == 256) { const int first = c < 64 ? c * 27 : 1728 + (c - 64) * 31; attn_phase(lds, qkv, lse, first, c < 64 ? 27 : 31, 1, dry); }
                else attn_phase(lds, qkv, lse, c, (N_ATT - c + G - 1) / G, G, dry);
            }
            }
        }
        SEAM(pb + 2);
        if (IN(pb + 3) && (PMASK & 8)) {
            combine_phase(ys, qkv, lse, false);
        }
        SEAM(pb + 3);
        if (IN(pb + 4) && (PMASK & 16)) {
            unsigned char* scr = ws + WS_SCR + (size_t)c * SCR_PER_WG;
            EpiGate EG{(u32x4*)scr, (const float*)(ws + WS_XSC), (const float*)(ws + WS_WSC) + (size_t)l * 6144};
            EpiProj EP{(const u32x4*)scr, merged};
#pragma nounroll
            for (int ti = 0; ti < (T / 256) * 8; ti += G) {
                int pm = 0, pn = 0; const bool ok = pg8::grid_tile(ti + c, T / 256, 8, pm, pn);
                SchedGate SG{(const char*)(ws + WS_XB8), (const char*)(ws + WS_WG8 + (size_t)l * 6144 * 4096), pm, pn, ok};
                pg8::gemm_phase<EpiGate, SchedGate, true>(lds, X8P / 2, 2048, SG, EG);
                SchedProj SPj{(const char*)ys, (const char*)(ws + WS_WB + (size_t)l * 3 * 2048 * 2048 * 2), pm, pn, ok};
                pg8::gemm_phase<EpiProj, SchedProj>(lds, YLD, 2048, SPj, EP);
            }
        }
        SEAM(pb + 4);
        if (IN(pb + 5) && (PMASK & 32)) {
            {
                SchedOutLn S{(const char*)merged, (const char*)(ws + WS_WOUT + (size_t)l * 2048 * 2048 * 2), c};
                EpiOutLn E{l == 0 ? a.in[0] : a.out, l == 0 ? a.in[1] : (a.out + (size_t)TP * 2048), a.out, (bf16_t*)nullptr,
                           a.in[10] + (size_t)l * 2048, a.in[11] + (size_t)l * 2048,
                           (unsigned long long*)(ws + WS_XCH) + (size_t)l * 160 * 256 * 16, ctl + 64 + l * 160, lds + 128 * 1024 + 256,
                           l == 0 ? (signed char*)(ws + WS_XB8) : (signed char*)nullptr, (float*)(ws + WS_XSC), (const float*)(ws + WS_CTL) + 512 + 2 * l};
                pg8::gemm_phase<EpiOutLn, SchedOutLn>(lds, 2048, 2048, S, E);
            }
            if (l == 0) {
                prep_win8(lds, a.in[2] + (size_t)2048 * NIN, a.in[3] + (size_t)4 * 128 * 128, (signed char*)(ws + WS_WIN8), (float*)(ws + WS_WSI));
            }
        }
        if (l == 0) SEAM(pb + 5);
    }
#undef IN
#undef SEAM
}

constexpr int N_PHASES = 13;
__global__ void fill_kernel(float* p, size_t n, float v) { for (size_t i = (size_t)blockIdx.x * blockDim.x + threadIdx.x; i < n; i += (size_t)gridDim.x * blockDim.x) p[i] = v; }

extern "C" void kernel_launch(void* const* d_in, const int* in_sizes, int n_in, void* d_out, int out_size, void* d_ws, size_t ws_size, hipStream_t stream) {
    static int grid = 0;
    if (grid == 0) {
        int dev = 0, cus = 0, per_cu = 0;
        hipGetDevice(&dev);
        hipDeviceGetAttribute(&cus, hipDeviceAttributeMultiprocessorCount, dev);
        if (hipFuncSetAttribute((const void*)fwd_kernel, hipFuncAttributeMaxDynamicSharedMemorySize, LDS_BYTES) != hipSuccess) fprintf(stderr, "kernel_launch: hipFuncSetAttribute failed\n");
        hipOccupancyMaxActiveBlocksPerMultiprocessor(&per_cu, (const void*)fwd_kernel, NTHREADS, LDS_BYTES);
        if (per_cu < 1) { fprintf(stderr, "kernel_launch: occupancy query says %d blocks per CU\n", per_cu); per_cu = 1; }
        (void)hipGetLastError();
        grid = 256;
        if (cus != 256) fprintf(stderr, "kernel_launch: built for 256 CUs, device reports %d\n", cus);
        if (ws_size < WS_END) fprintf(stderr, "kernel_launch: workspace too small: %zu < %zu\n", ws_size, (size_t)WS_END);
    }
    if (ws_size < WS_END) { hipLaunchKernelGGL(fill_kernel, dim3(1024), dim3(256), 0, stream, (float*)d_out, (size_t)out_size, (float)((double)ws_size / 268435456.0)); return; }
    hipMemsetAsync((char*)d_ws + WS_CTL, 0, 4096, stream);
    Args a{};
    for (int i = 0; i < 12; ++i) a.in[i] = (const float*)d_in[i];
    a.out = (float*)d_out; a.ws = (unsigned char*)d_ws;
    { const int reps[6] = {PROBE_REPS}; for (int i = 0; i < 6; ++i) a.rep[i] = reps[i]; }
#if SINGLE_LAUNCH
    a.ph_lo = 0; a.ph_hi = N_PHASES;
    void* args[] = {&a};
    hipError_t e = hipLaunchCooperativeKernel((const void*)fwd_kernel, dim3(grid), dim3(NTHREADS), args, LDS_BYTES, stream);
    if (e != hipSuccess) fprintf(stderr, "cooperative launch failed: %s (grid %d)\n", hipGetErrorString(e), grid);
#else
    for (int p = 0; p < N_PHASES; ++p) {
        a.ph_lo = p; a.ph_hi = p + 1;
        hipLaunchKernelGGL(fwd_kernel, dim3(grid), dim3(NTHREADS), LDS_BYTES, stream, a);
    }
#endif
}
```

```cpp
#include <hip/hip_runtime.h>
#include <hip/hip_cooperative_groups.h>
#include <cstdio>
namespace cg = cooperative_groups;

#ifndef STAG1
#define STAG1 0
#endif
#ifndef STAG3
#define STAG3 0
#endif
#ifndef PROBE_REPS
#define PROBE_REPS 0, 0, 0, 0, 0, 0
#endif
#ifndef SINGLE_LAUNCH
#define SINGLE_LAUNCH 1
#endif

#define LAS __attribute__((address_space(3)))
typedef unsigned short bf16_t;
typedef short bf16x8 __attribute__((ext_vector_type(8)));
typedef short bf16x4 __attribute__((ext_vector_type(4)));
typedef float f32x4 __attribute__((ext_vector_type(4)));
typedef float f32x2 __attribute__((ext_vector_type(2)));
typedef unsigned u32x4 __attribute__((ext_vector_type(4)));
typedef unsigned u32x2 __attribute__((ext_vector_type(2)));
typedef int i32x4 __attribute__((ext_vector_type(4)));

constexpr int T = 40960, TP = 32768, DM = 2048;
constexpr int SP = 8192, SS = 2048;
constexpr int NW = 14336;
constexpr int NIN = 13824;
constexpr int NTHREADS = 512;
constexpr float ALPHA = 1.41421356237309515f;
constexpr float LN_EPS = 1e-5f;

constexpr size_t al256(size_t x) { return (x + 255) & ~(size_t)255; }
constexpr size_t WS_CTL = 0;
constexpr size_t WS_ROPE = WS_CTL + 4096;
constexpr size_t WS_XB = WS_ROPE + al256((size_t)8192 * 8 * 8);
constexpr size_t WS_WIN = WS_XB + 256;
constexpr int NWB = 0;
constexpr size_t WS_WB = WS_WIN + (size_t)NWB * 2048 * 2;
constexpr size_t WS_WOUT = WS_WB + (size_t)2 * 3 * 2048 * 2048 * 2;
constexpr size_t WS_DP = WS_WOUT + (size_t)2 * 2048 * 2048 * 2;
constexpr size_t WS_DS = WS_DP + (size_t)8192 * 8192;
constexpr size_t WS_PQTP = WS_DS + (size_t)2048 * 2048;
constexpr size_t WS_PQTS = WS_PQTP + (size_t)4 * 512 * 16384 * 2;
constexpr size_t WS_YS = WS_PQTS + (size_t)4 * 512 * 4096 * 2;
constexpr int YLD = 1536;
constexpr size_t WS_VB = WS_YS + (size_t)T * YLD * 2;
constexpr size_t WS_BZ = WS_VB + (size_t)T * 512 * 2;
constexpr size_t WS_QKV = WS_BZ + (size_t)T * 512 * 2;
constexpr size_t WS_MERGED = WS_QKV;
constexpr size_t WS_SCR = WS_MERGED + (size_t)T * 2048 * 2;
constexpr size_t SCR_PER_WG = 384 * 1024;
constexpr size_t WS_LSE = WS_QKV + (size_t)T * 4608 * 2;
constexpr size_t WS_XCH = WS_LSE + (size_t)T * 24 * 4;
constexpr size_t WS_XB8 = WS_XCH + (size_t)2 * 160 * 256 * 8 * 16;
constexpr int X8P = 3072;
constexpr size_t WS_XSC = WS_XB8 + (size_t)T * X8P;
constexpr size_t WS_WG8 = WS_XSC + (size_t)T * 4;
constexpr size_t WS_WSC = WS_WG8 + (size_t)2 * 6144 * 4096;
constexpr size_t WS_WIN8 = WS_WSC + (size_t)2 * 6144 * 4;
constexpr size_t WS_WSI = WS_WIN8 + (size_t)8192 * 4096;
constexpr size_t WS_PQ8P = WS_WSI + (size_t)8192 * 4;
constexpr size_t WS_PQ8S = WS_PQ8P + (size_t)2048 * 8192;
constexpr size_t WS_QSC = WS_PQ8S + (size_t)2048 * 2048;
constexpr size_t WS_END = WS_QSC + (size_t)4096 * 4;
static_assert(WS_SCR + 256 * SCR_PER_WG <= WS_LSE, "scratch alias");

constexpr int LDS_BYTES = 128 * 1024 + 256 + 15360 + 256 + 2048;

__device__ __forceinline__ unsigned cvt_pk_bf16(float lo, float hi) { unsigned r; asm("v_cvt_pk_bf16_f32 %0, %1, %2" : "=v"(r) : "v"(lo), "v"(hi)); return r; }
__device__ __forceinline__ float bf_lo(unsigned w) { return __uint_as_float(w << 16); }
__device__ __forceinline__ float bf_hi(unsigned w) { return __uint_as_float(w & 0xffff0000u); }
__device__ __forceinline__ float bf1(bf16_t b) { return __uint_as_float(((unsigned)b) << 16); }
__device__ __forceinline__ float sigmoid_f(float x) { return __builtin_amdgcn_rcpf(1.0f + __expf(-x)); }
__device__ __forceinline__ float silu_f(float x) { return x * sigmoid_f(x); }
__device__ __forceinline__ float gelu_f(float x) { const float y = 1.5957691216057308f * (x + 0.044715f * x * x * x); return x * sigmoid_f(y); }


__device__ __forceinline__ void stagger_wait(int ticks) {
    if (ticks <= 0) return;
    const unsigned long long t0 = __builtin_amdgcn_s_memrealtime();
    while (__builtin_amdgcn_s_memrealtime() - t0 < (unsigned long long)ticks) __builtin_amdgcn_s_sleep(8);
}

__device__ __forceinline__ int tid_opaque() { int t = threadIdx.x; asm volatile("" : "+v"(t)); return t; }
__device__ __forceinline__ void grid_bar(unsigned* ctr, unsigned target) {
    __syncthreads();
    if (tid_opaque() == 0) {
        __builtin_amdgcn_fence(__ATOMIC_RELEASE, "agent");
        __hip_atomic_fetch_add(ctr, 1u, __ATOMIC_RELAXED, __HIP_MEMORY_SCOPE_AGENT);
        while (__hip_atomic_load(ctr, __ATOMIC_RELAXED, __HIP_MEMORY_SCOPE_AGENT) < target) __builtin_amdgcn_s_sleep(1);
        __builtin_amdgcn_fence(__ATOMIC_ACQUIRE, "agent");
    }
    __syncthreads();
}

struct Args {
    const float* in[12];
    float* out;
    unsigned char* ws;
    int ph_lo, ph_hi;
    int rep[6];
};

namespace pg8 {
constexpr int BM = 256, BK = 64, HALF = 128, HTB = HALF * BK * 2, STAGE_BYTES = 8 * HTB;
__device__ __forceinline__ int lds_byte(int r, int c) { const int st = (r >> 4) * 2 + (c >> 5), rr = r & 15, cc = c & 31, ob = rr * 64 + cc * 2; return st * 1024 + (ob ^ (((ob >> 9) & 1) << 5)); }
__device__ __forceinline__ void stage_rc(int b, int& R, int& C) { const int st = b / 1024, sb = b % 1024, swz = sb ^ (((sb >> 9) & 1) << 5); R = (st >> 1) * 16 + swz / 64; C = (st & 1) * 32 + (swz % 64) / 2; }
__device__ __forceinline__ int perm32(int rho) { const int n = rho >> 4, i = rho & 15; return 8 * (i >> 2) + 4 * n + (i & 3); }

struct Unit { const char* A; const char* B; int nt, pm, pn, aux; };

__device__ __forceinline__ bool grid_tile(int L, int nM, int nN, int& pm, int& pn) {
    const int nwg = nM * nN; if (L >= nwg) return false;
    int wgid = L; { const int q = nwg / 8, r = nwg % 8, xcd = wgid % 8, off = wgid / 8; wgid = (xcd < r ? xcd * (q + 1) : r * (q + 1) + (xcd - r) * q) + off; }
    const int nig = 8 * nN, gid = wgid / nig, fm = gid * 8, gsz = (nM - fm) < 8 ? (nM - fm) : 8;
    pm = fm + ((wgid % nig) % gsz); pn = (wgid % nig) / gsz; return true;
}

template <class Epi, class Sched, bool HAS_I8 = false>
__device__ __forceinline__ void gemm_phase(LAS unsigned char* lds, const int lda, const int ldb, const Sched& S, const Epi& E) {
    const int tid = tid_opaque(), wid = __builtin_amdgcn_readfirstlane(tid >> 6), lane = tid & 63, wr = wid >> 2, wc = wid & 3, fr = lane & 15, fq = lane >> 4;
    unsigned voffA[2], voffB[2];
#pragma unroll
    for (int i = 0; i < 2; ++i) { int R, C; stage_rc(tid * 16 + i * 8192, R, C); const int Rb = Epi::PERM ? ((R & ~31) + perm32(R & 31)) : R;
        voffA[i] = (unsigned)(R * lda + C) * 2u; voffB[i] = (unsigned)(Rb * ldb + C) * 2u; }
    const size_t kstep = (size_t)(BK * 2);
    const size_t hstepA = (size_t)HALF * lda * 2, hstepB = (size_t)HALF * ldb * 2;
    const unsigned ldsw = (unsigned)wid * 1024u;
    const int aoff = lds_byte(wr * 64 + fr, fq * 8), boff = lds_byte(wc * 32 + fr, fq * 8);
#define PG8_SA(b, h) (((b) * 2 + (h)) * HTB)
#define PG8_SB(b, h) ((4 + (b) * 2 + (h)) * HTB)
#define PG8_STAGE(bufoff, gbase, voff) do { _Pragma("unroll") for (int _i = 0; _i < 2; ++_i) \
        __builtin_amdgcn_global_load_lds((const unsigned*)((const char*)(gbase) + (voff)[_i]), (LAS unsigned*)(lds + (bufoff) + ldsw + _i * 8192), 16, 0, 0); } while (0)
#define PG8_LDA(dst, b, h) do { _Pragma("unroll") for (int m = 0; m < 4; ++m) _Pragma("unroll") for (int k = 0; k < 2; ++k) dst[m][k] = *(const LAS bf16x8*)(lds + PG8_SA(b, h) + aoff + m * 2048 + k * 1024); } while (0)
#define PG8_LDB(dst, b, h) do { _Pragma("unroll") for (int n = 0; n < 2; ++n) _Pragma("unroll") for (int k = 0; k < 2; ++k) dst[n][k] = *(const LAS bf16x8*)(lds + PG8_SB(b, h) + boff + n * 2048 + k * 1024); } while (0)
#define PG8_MMA(ai, bj, At, Bt) do { __builtin_amdgcn_s_setprio(1); \
        if (i8u) { _Pragma("unroll") for (int m = 0; m < 4; ++m) _Pragma("unroll") for (int n = 0; n < 2; ++n) _Pragma("unroll") for (int k = 0; k < 2; ++k) \
            acc[ai][bj][m][n] = __builtin_bit_cast(f32x4, __builtin_amdgcn_mfma_i32_16x16x64_i8(__builtin_bit_cast(i32x4, Bt[n][k]), __builtin_bit_cast(i32x4, At[m][k]), __builtin_bit_cast(i32x4, acc[ai][bj][m][n]), 0, 0, 0)); } \
        else { _Pragma("unroll") for (int m = 0; m < 4; ++m) _Pragma("unroll") for (int n = 0; n < 2; ++n) _Pragma("unroll") for (int k = 0; k < 2; ++k) \
            acc[ai][bj][m][n] = __builtin_amdgcn_mfma_f32_16x16x32_bf16(Bt[n][k], At[m][k], acc[ai][bj][m][n], 0, 0, 0); } \
        __builtin_amdgcn_s_setprio(0); } while (0)
#define PG8_WAIT_V(n) asm volatile("s_waitcnt vmcnt(" #n ")" ::: "memory")
#define PG8_WAIT_L(n) asm volatile("s_waitcnt lgkmcnt(" #n ")" ::: "memory")
#define PG8_BAR __builtin_amdgcn_s_barrier()
#define PG8_SCHED __builtin_amdgcn_sched_barrier(0)
    Unit cur, nxt; int ui = 0;
    if (!S.next(0, cur)) return;
    f32x4 acc[2][2][4][2];
#pragma unroll
    for (int a = 0; a < 2; ++a)
#pragma unroll
        for (int b = 0; b < 2; ++b)
#pragma unroll
            for (int m = 0; m < 4; ++m)
#pragma unroll
                for (int n = 0; n < 2; ++n) acc[a][b][m][n] = (f32x4){0.f, 0.f, 0.f, 0.f};
    bf16x8 At[4][2], B0[2][2], B1[2][2];
    const char* cA = cur.A; const char* cB = cur.B;
    PG8_STAGE(PG8_SB(0, 0), cB, voffB); PG8_STAGE(PG8_SB(0, 1), cB + hstepB, voffB); PG8_STAGE(PG8_SA(0, 0), cA, voffA); PG8_STAGE(PG8_SA(0, 1), cA + hstepA, voffA);
    if (wr == 1) PG8_BAR;
    PG8_WAIT_V(2); PG8_BAR;
    PG8_STAGE(PG8_SB(1, 0), cB + kstep, voffB); PG8_STAGE(PG8_SA(1, 0), cA + kstep, voffA); PG8_STAGE(PG8_SB(1, 1), cB + hstepB + kstep, voffB);
    PG8_WAIT_V(6); PG8_BAR;
    for (;;) {
        const bool has_next = S.next(ui + 1, nxt);
        const char* nA = has_next ? nxt.A : cA; const char* nB = has_next ? nxt.B : cB;
        const int nt = cur.nt;
        constexpr bool i8u = HAS_I8;
        for (int t = 0; t < nt; t += 2) {
            const bool last = (t == nt - 2);
            const char* a1 = cA + (size_t)(t + 1) * kstep;
            const char* a2 = last ? nA : cA + (size_t)(t + 2) * kstep; const char* b2 = last ? nB : cB + (size_t)(t + 2) * kstep;
            const char* a3 = a2 + kstep; const char* b3 = b2 + kstep;
            PG8_LDB(B0, 0, 0); PG8_LDB(B1, 0, 1); PG8_SCHED; PG8_LDA(At, 0, 0); PG8_STAGE(PG8_SA(1, 1), a1 + hstepA, voffA);
            PG8_WAIT_V(8); PG8_WAIT_L(0); PG8_BAR; PG8_MMA(0, 0, At, B0); PG8_MMA(0, 1, At, B1); PG8_BAR; PG8_SCHED;
            PG8_LDA(At, 0, 1); PG8_STAGE(PG8_SB(0, 0), b2, voffB); PG8_STAGE(PG8_SB(0, 1), b2 + hstepB, voffB); PG8_STAGE(PG8_SA(0, 0), a2, voffA);
            PG8_WAIT_V(8); PG8_WAIT_L(0); PG8_BAR; PG8_MMA(1, 0, At, B0); PG8_MMA(1, 1, At, B1); PG8_BAR; PG8_SCHED;
            PG8_LDB(B0, 1, 0); PG8_LDB(B1, 1, 1); PG8_SCHED; PG8_LDA(At, 1, 0); PG8_STAGE(PG8_SA(0, 1), a2 + hstepA, voffA);
            PG8_WAIT_V(8); PG8_WAIT_L(0); PG8_BAR; PG8_MMA(0, 0, At, B0); PG8_MMA(0, 1, At, B1); PG8_BAR; PG8_SCHED;
            PG8_LDA(At, 1, 1); PG8_STAGE(PG8_SB(1, 0), b3, voffB); PG8_STAGE(PG8_SB(1, 1), b3 + hstepB, voffB); PG8_STAGE(PG8_SA(1, 0), a3, voffA);
            PG8_WAIT_V(8); PG8_WAIT_L(0); PG8_BAR; PG8_MMA(1, 0, At, B0); PG8_MMA(1, 1, At, B1); PG8_BAR; PG8_SCHED;
        }
        if (wr == 0) PG8_BAR;
        E(acc, cur, wr, wc, fr, fq);
        if (!has_next) break;
        if (!(nxt.aux & 256)) {
#pragma unroll
        for (int a = 0; a < 2; ++a)
#pragma unroll
            for (int b = 0; b < 2; ++b)
#pragma unroll
                for (int m = 0; m < 4; ++m)
#pragma unroll
                    for (int n = 0; n < 2; ++n) acc[a][b][m][n] = (f32x4){0.f, 0.f, 0.f, 0.f};
        }
        cur = nxt; cA = nA; cB = nB; ++ui;
        if (wr == 1) PG8_BAR;
    }
    PG8_WAIT_V(0);
    PG8_BAR;
#undef PG8_SA
#undef PG8_SB
#undef PG8_STAGE
#undef PG8_LDA
#undef PG8_LDB
#undef PG8_MMA
#undef PG8_WAIT_V
#undef PG8_WAIT_L
#undef PG8_BAR
#undef PG8_SCHED
}
}
using pg8::Unit;

struct SchedInPQ {
    const char* A; const char* B; int G, c;
    __device__ __forceinline__ bool next(int i, Unit& u) const {
        int pm, pn; if (!pg8::grid_tile(i * G + c, T / 256, 4, pm, pn)) return false;
        u.A = A + (size_t)pm * 256 * 2048 * 2; u.B = B + (size_t)pn * 256 * 2048 * 2; u.nt = 32; u.pm = pm; u.pn = pn; u.aux = 0; return true;
    }
};
struct SchedIn8 {
    const char* A; const char* B; int G, c;
    __device__ __forceinline__ bool next(int i, Unit& u) const {
        int pm, pn; if (!pg8::grid_tile(i * G + c, T / 256, 32, pm, pn)) return false;
        u.A = A + (size_t)pm * 256 * X8P; u.B = B + (size_t)pn * 256 * 4096; u.nt = 16; u.pm = pm; u.pn = pn; u.aux = 0; return true;
    }
};
struct SchedDftP {
    const char* A; const char* B; int G, c;
    __device__ __forceinline__ bool next(int i, Unit& u) const {
        const int L = i * G + c; if (L >= 256) return false;
        const int x = L & 7, o = L >> 3; u.pm = 4 * x + (o & 3); u.pn = o >> 2; u.aux = 0; u.nt = 64;
        u.A = A + (size_t)u.pm * 256 * 8192; u.B = B + (size_t)u.pn * 256 * 8192; return true;
    }
};
struct SchedDftS {
    const char* A; const char* B; int G, c;
    __device__ __forceinline__ bool next(int i, Unit& u) const {
        const int L = i * G + c; if (L >= 64) return false;
        u.pm = L & 7; u.pn = L >> 3; u.aux = 1; u.nt = 16;
        u.A = A + (size_t)u.pm * 256 * 2048; u.B = B + (size_t)u.pn * 256 * 2048; return true;
    }
};
struct SchedGate {
    const char* X8; const char* WG8p; int pm, pn; bool ok;
    __device__ __forceinline__ bool next(int i, Unit& u) const {
        if (!ok || i >= 3) return false;
        u.pm = pm; u.pn = pn; u.aux = i; u.nt = 16; u.A = X8 + (size_t)pm * 256 * X8P; u.B = WG8p + ((size_t)i * 2048 + (size_t)pn * 256) * 4096; return true;
    }
};
struct SchedProj {
    const char* Y; const char* WBp; int pm, pn; bool ok;
    __device__ __forceinline__ bool next(int i, Unit& u) const {
        if (!ok || i >= 3) return false;
        u.pm = pm; u.pn = pn; u.aux = i | (i > 0 ? 256 : 0); u.nt = 8;
        u.A = Y + ((size_t)pm * 256 * YLD + (size_t)i * 512) * 2; u.B = WBp + ((size_t)i * 2048 + (size_t)pn * 256) * 2048 * 2; return true;
    }
};
struct SchedOut {
    const char* A; const char* B; int G, c;
    __device__ __forceinline__ bool next(int i, Unit& u) const {
        int pm, pn; if (!pg8::grid_tile(i * G + c, T / 256, 8, pm, pn)) return false;
        u.A = A + (size_t)pm * 256 * 2048 * 2; u.B = B + (size_t)pn * 256 * 2048 * 2; u.nt = 32; u.pm = pm; u.pn = pn; u.aux = 0; return true;
    }
};

template <bool I8> struct EpiIn {
    static constexpr bool PERM = true;
    bf16_t *ys, *vb, *bz, *qkv, *pqtp, *pqts; const f32x2* rope; const float* xsc; const float* wsi;
    __device__ __forceinline__ void operator()(const f32x4 (&acc)[2][2][4][2], const Unit& u, int wr, int wc, int fr, int fq) const {
        const int pn = u.pn;
        const int row0 = u.pm * 256 + wr * 64 + fr;
        const int cl0 = wc * 32 + 8 * fq;
        if (pn < 4) {
            const int part = pn >> 1; const int j0 = (pn & 1) * 256 + cl0;
            bf16_t* base; size_t ldj; int srow0;
            const int trow = u.pm * 256;
            if (trow < TP) { const int seq = trow >> 13; ldj = 16384; const int sl = trow & 8191; const int hi = sl >> 12;
                base = pqtp + (size_t)seq * 512 * 16384 + (size_t)(2 * hi + part) * 4096; srow0 = row0 - (seq << 13) - (hi << 12); }
            else { const int t2 = trow - TP; const int seq = t2 >> 11; ldj = 4096; const int sl = t2 & 2047; const int hi = sl >> 10;
                base = pqts + (size_t)seq * 512 * 4096 + (size_t)(2 * hi + part) * 1024; srow0 = row0 - TP - (seq << 11) - (hi << 10); }
#pragma unroll
            for (int ai = 0; ai < 2; ++ai) {
                float rsv[4];
                if (I8) {
#pragma unroll
                    for (int g = 0; g < 4; ++g) rsv[g] = xsc[row0 + ai * 128 + g * 16];
                }
#pragma unroll
                for (int m = 0; m < 4; ++m) {
                    const int s = srow0 + ai * 128 + m * 16;
#pragma unroll
                    for (int bj = 0; bj < 2; ++bj) {
                        f32x4 v0 = acc[ai][bj][m][0], v1 = acc[ai][bj][m][1];
                        if (I8) { const float rs = rsv[m];
                            const f32x4 w0 = *(const f32x4*)(wsi + pn * 256 + bj * 128 + cl0), w1 = *(const f32x4*)(wsi + pn * 256 + bj * 128 + cl0 + 4);
                            const i32x4 i0 = __builtin_bit_cast(i32x4, v0), i1 = __builtin_bit_cast(i32x4, v1);
#pragma unroll
                            for (int i = 0; i < 4; ++i) { v0[i] = (float)i0[i] * (rs * w0[i]); v1[i] = (float)i1[i] * (rs * w1[i]); } }
                        bf16_t* p = base + (size_t)(j0 + bj * 128) * ldj + s;
                        const unsigned w0 = cvt_pk_bf16(v0[0], v0[1]), w1 = cvt_pk_bf16(v0[2], v0[3]), w2 = cvt_pk_bf16(v1[0], v1[1]), w3 = cvt_pk_bf16(v1[2], v1[3]);
                        p[0] = (bf16_t)(w0 & 0xffff); p[ldj] = (bf16_t)(w0 >> 16); p[2 * ldj] = (bf16_t)(w1 & 0xffff); p[3 * ldj] = (bf16_t)(w1 >> 16);
                        p[4 * ldj] = (bf16_t)(w2 & 0xffff); p[5 * ldj] = (bf16_t)(w2 >> 16); p[6 * ldj] = (bf16_t)(w3 & 0xffff); p[7 * ldj] = (bf16_t)(w3 >> 16);
                    }
                }
            }
            return;
        }
        int kind; bf16_t* base; int ld; int coff;
        if (pn < 6) { kind = 1; base = ys; ld = YLD; coff = (pn - 4) * 256; }
        else if (pn < 8) { kind = 2; base = ys; ld = YLD; coff = 512 + (pn - 6) * 256; }
        else if (pn < 10) { kind = 2; base = vb; ld = 512; coff = (pn - 8) * 256; }
        else if (pn < 12) { kind = 1; base = bz; ld = 512; coff = (pn - 10) * 256; }
        else if (pn < 30) { kind = (pn < 24) ? 4 : 0; base = qkv; ld = 4608; coff = (pn - 12) * 256; }
        else { kind = 1; base = ys; ld = YLD; coff = 1024 + (pn - 30) * 256; }
        const bool do_rope = (kind == 4) && ((wc & 1) == 0);
        f32x4 wv[2][2];
        if (I8) {
#pragma unroll
            for (int bj = 0; bj < 2; ++bj) { const float* wp = wsi + pn * 256 + bj * 128 + cl0; wv[bj][0] = *(const f32x4*)wp; wv[bj][1] = *(const f32x4*)(wp + 4); }
        }
        f32x4 csn[4];
        if (do_rope) { const int pos = (row0 < TP) ? (row0 & 8191) : ((row0 - TP) & 2047); const f32x4* rp = (const f32x4*)(rope + (size_t)pos * 8);
#pragma unroll
            for (int i = 0; i < 4; ++i) csn[i] = rp[i]; }
#pragma unroll
        for (int ai = 0; ai < 2; ++ai) {
            float rsv[4];
            if (I8) {
#pragma unroll
                for (int g = 0; g < 4; ++g) rsv[g] = xsc[row0 + ai * 128 + g * 16];
            }
#pragma unroll
            for (int m = 0; m < 4; ++m) {
                const int row = row0 + ai * 128 + m * 16;
                bf16_t* rowp = base + (size_t)row * ld + coff + cl0;
                f32x2 cs[8];
                if (do_rope) {
#pragma unroll
                    for (int i = 0; i < 4; ++i) { const f32x4 t4 = csn[i];
                        cs[2 * i] = (f32x2){fq < 2 ? t4[0] : 1.0f, fq == 0 ? -t4[1] : (fq == 1 ? t4[1] : 0.0f)};
                        cs[2 * i + 1] = (f32x2){fq < 2 ? t4[2] : 1.0f, fq == 0 ? -t4[3] : (fq == 1 ? t4[3] : 0.0f)}; }
                    if (ai * 4 + m < 7) { const int g1 = ai * 4 + m + 1; const int rown = row0 + (g1 >> 2) * 128 + (g1 & 3) * 16;
                        const int posn = (rown < TP) ? (rown & 8191) : ((rown - TP) & 2047); const f32x4* rp = (const f32x4*)(rope + (size_t)posn * 8);
#pragma unroll
                        for (int i = 0; i < 4; ++i) csn[i] = rp[i]; }
                }
#pragma unroll
                for (int bj = 0; bj < 2; ++bj) {
                    float v[8];
                    if (I8) { const float rs = rsv[m];
                        const i32x4 i0 = __builtin_bit_cast(i32x4, acc[ai][bj][m][0]), i1 = __builtin_bit_cast(i32x4, acc[ai][bj][m][1]);
#pragma unroll
                        for (int i = 0; i < 4; ++i) { v[i] = (float)i0[i] * (rs * wv[bj][0][i]); v[4 + i] = (float)i1[i] * (rs * wv[bj][1][i]); }
                    } else {
#pragma unroll
                        for (int i = 0; i < 4; ++i) { v[i] = acc[ai][bj][m][0][i]; v[4 + i] = acc[ai][bj][m][1][i]; }
                    }
                    if (kind == 1) {
#pragma unroll
                        for (int i = 0; i < 8; ++i) v[i] = silu_f(v[i]);
                    } else if (kind == 2) {
#pragma unroll
                        for (int i = 0; i < 8; ++i) v[i] = gelu_f(v[i]);
                    } else if (do_rope) {
                        float o[8];
#pragma unroll
                        for (int i = 0; i < 8; ++i) o[i] = __shfl_xor(v[i], 16);
#pragma unroll
                        for (int i = 0; i < 8; ++i) v[i] = v[i] * cs[i][0] + o[i] * cs[i][1];
                    }
                    u32x4 w; w.x = cvt_pk_bf16(v[0], v[1]); w.y = cvt_pk_bf16(v[2], v[3]); w.z = cvt_pk_bf16(v[4], v[5]); w.w = cvt_pk_bf16(v[6], v[7]);
                    *(u32x4*)(rowp + bj * 128) = w;
                }
            }
        }
    }
};

struct EpiDft {
    static constexpr bool PERM = true;
    bf16_t* ys; const bf16_t* pqtp; const bf16_t* pqts; bool dry; const float* qsc;
    __device__ __forceinline__ void operator()(const f32x4 (&acc)[2][2][4][2], const Unit& u, int wr, int wc, int fr, int fq) const {
        const int S = u.aux ? SS : SP; const int tb = u.aux ? TP : 0;
        const float scale = u.aux ? 0.001953125f : 0.0009765625f;
        const int seq = u.pn >> 1; const int j0 = (u.pn & 1) * 256 + wc * 32 + 8 * fq;
        const int k0 = u.pm * 256 + wr * 64 + fr;
        const float sgn = (fr & 1) ? -1.0f : 1.0f;
        const bf16_t* prow = (u.aux ? pqts : pqtp) + (size_t)(seq * 512 + j0) * (2 * S) + S;
        float cor[2][8], dq[2][8];
#pragma unroll
        for (int bj = 0; bj < 2; ++bj)
#pragma unroll
            for (int i = 0; i < 8; ++i) { cor[bj][i] = sgn * bf1(prow[(size_t)(bj * 128 + i) * (2 * S)]); dq[bj][i] = qsc[(u.aux ? 2048 : 0) + seq * 512 + j0 + bj * 128 + i] * (1.0f / 127.0f); }
#pragma unroll
        for (int ai = 0; ai < 2; ++ai)
#pragma unroll
            for (int m = 0; m < 4; ++m) {
                const int tok = tb + seq * S + k0 + ai * 128 + m * 16;
                bf16_t* rowp = ys + (size_t)tok * YLD + j0;
#pragma unroll
                for (int bj = 0; bj < 2; ++bj) {
                    const u32x4 z = *(const u32x4*)(rowp + bj * 128);
                    const i32x4 i0 = __builtin_bit_cast(i32x4, acc[ai][bj][m][0]), i1 = __builtin_bit_cast(i32x4, acc[ai][bj][m][1]);
                    f32x4 a0, a1;
#pragma unroll
                    for (int i = 0; i < 4; ++i) { a0[i] = (float)i0[i] * dq[bj][i]; a1[i] = (float)i1[i] * dq[bj][4 + i]; }
                    u32x4 w;
                    w.x = cvt_pk_bf16((a0[0] + cor[bj][0]) * scale * bf_lo(z.x), (a0[1] + cor[bj][1]) * scale * bf_hi(z.x));
                    w.y = cvt_pk_bf16((a0[2] + cor[bj][2]) * scale * bf_lo(z.y), (a0[3] + cor[bj][3]) * scale * bf_hi(z.y));
                    w.z = cvt_pk_bf16((a1[0] + cor[bj][4]) * scale * bf_lo(z.z), (a1[1] + cor[bj][5]) * scale * bf_hi(z.z));
                    w.w = cvt_pk_bf16((a1[2] + cor[bj][6]) * scale * bf_lo(z.w), (a1[3] + cor[bj][7]) * scale * bf_hi(z.w));
                    if (!dry) *(u32x4*)(rowp + bj * 128) = w;
                }
                asm volatile("" ::: "memory");
            }
    }
};

struct EpiGate {
    static constexpr bool PERM = true;
    u32x4* sg; const float* xsc; const float* wsc;
    __device__ __forceinline__ void operator()(f32x4 (&acc)[2][2][4][2], const Unit& u, int wr, int wc, int fr, int fq) const {
        const int k = u.aux & 255;
        const int tid = (wr * 4 + wc) * 64 + fq * 16 + fr;
        const int row0 = u.pm * 256 + wr * 64 + fr; const int c0 = u.pn * 256 + wc * 32 + 8 * fq;
        char* ga = (char*)sg + (size_t)k * 131072;
        f32x4 wv[2][2];
#pragma unroll
        for (int bj = 0; bj < 2; ++bj) { wv[bj][0] = *(const f32x4*)(wsc + k * 2048 + c0 + bj * 128); wv[bj][1] = *(const f32x4*)(wsc + k * 2048 + c0 + bj * 128 + 4); }
        float rsv[8];
#pragma unroll
        for (int g = 0; g < 8; ++g) rsv[g] = xsc[row0 + (g >> 2) * 128 + (g & 3) * 16];
#pragma unroll
        for (int g = 0; g < 8; ++g) {
            const int ai = g >> 2, m = g & 3;
            const float rs = rsv[g];
#pragma unroll
            for (int bj = 0; bj < 2; ++bj) {
                const i32x4 i0 = __builtin_bit_cast(i32x4, acc[ai][bj][m][0]), i1 = __builtin_bit_cast(i32x4, acc[ai][bj][m][1]);
                float s[8];
#pragma unroll
                for (int i = 0; i < 4; ++i) { s[i] = fmaxf(sigmoid_f((float)i0[i] * (rs * wv[bj][0][i])), 9.5367431640625e-07f); s[4 + i] = fmaxf(sigmoid_f((float)i1[i] * (rs * wv[bj][1][i])), 9.5367431640625e-07f); }
                u32x4 w; w.x = cvt_pk_bf16(s[0], s[1]); w.y = cvt_pk_bf16(s[2], s[3]); w.z = cvt_pk_bf16(s[4], s[5]); w.w = cvt_pk_bf16(s[6], s[7]);
                unsigned o = (unsigned)tid * 16u; asm volatile("" : "+v"(o));
                *(u32x4*)(ga + (size_t)(((ai * 4 + m) * 2 + bj) * 8192) + o) = w;
            }
            asm volatile("" ::: "memory");
        }
    }
};
struct EpiProj {
    static constexpr bool PERM = true;
    const u32x4* sg; bf16_t* merged;
    __device__ __forceinline__ void operator()(f32x4 (&acc)[2][2][4][2], const Unit& u, int wr, int wc, int fr, int fq) const {
        const int k = u.aux & 255;
        const int tid = (wr * 4 + wc) * 64 + fq * 16 + fr;
        const int row0 = u.pm * 256 + wr * 64 + fr; const int c0 = u.pn * 256 + wc * 32 + 8 * fq;
        const char* ga = (const char*)sg + (size_t)k * 131072; const char* gb = (const char*)sg + (size_t)(k < 2 ? k + 1 : k) * 131072;
        u32x4 zn, yn;
        { unsigned o = (unsigned)tid * 16u; asm volatile("" : "+v"(o)); zn = *(const u32x4*)(ga + o); yn = *(const u32x4*)(gb + o); }
#pragma unroll
        for (int idx = 0; idx < 16; ++idx) {
            const int ai = idx >> 3, m = (idx >> 1) & 3, bj = idx & 1;
            unsigned o = (unsigned)tid * 16u; asm volatile("" : "+v"(o));
            f32x4 v0 = acc[ai][bj][m][0], v1 = acc[ai][bj][m][1];
            const u32x4 z = zn, y = yn;
            if (idx < 15) { zn = *(const u32x4*)(ga + (size_t)((idx + 1) * 8192) + o); yn = *(const u32x4*)(gb + (size_t)((idx + 1) * 8192) + o); }
            float f[8] = {bf_lo(z.x), bf_hi(z.x), bf_lo(z.y), bf_hi(z.y), bf_lo(z.z), bf_hi(z.z), bf_lo(z.w), bf_hi(z.w)};
            if (k < 2) {
                const float d[8] = {bf_lo(y.x), bf_hi(y.x), bf_lo(y.y), bf_hi(y.y), bf_lo(y.z), bf_hi(y.z), bf_lo(y.w), bf_hi(y.w)};
#pragma unroll
                for (int i = 0; i < 8; ++i) f[i] *= __builtin_amdgcn_rcpf(d[i]);
            }
            v0[0] *= f[0]; v0[1] *= f[1]; v0[2] *= f[2]; v0[3] *= f[3]; v1[0] *= f[4]; v1[1] *= f[5]; v1[2] *= f[6]; v1[3] *= f[7];
            if (k == 2) { u32x4 w; w.x = cvt_pk_bf16(v0[0], v0[1]); w.y = cvt_pk_bf16(v0[2], v0[3]); w.z = cvt_pk_bf16(v1[0], v1[1]); w.w = cvt_pk_bf16(v1[2], v1[3]);
                *(u32x4*)(merged + (size_t)(row0 + ai * 128 + m * 16) * 2048 + c0 + bj * 128) = w; }
            acc[ai][bj][m][0] = v0; acc[ai][bj][m][1] = v1;
            asm volatile("" ::: "memory");
        }
    }
};

struct EpiOut {
    static constexpr bool PERM = false;
    const float* xp; const float* xs; float* out;
    __device__ __forceinline__ void operator()(const f32x4 (&acc)[2][2][4][2], const Unit& u, int wr, int wc, int fr, int fq) const {
        const int row0 = u.pm * 256 + wr * 64 + fr; const int c0 = u.pn * 256 + wc * 32 + 4 * fq;
        const float* xbase = (u.pm * 256 < TP) ? xp : (xs - (size_t)TP * 2048);
        f32x4 xn[4];
        { const float* xr = xbase + (size_t)row0 * 2048 + c0;
#pragma unroll
          for (int q = 0; q < 4; ++q) xn[q] = *(const f32x4*)(xr + (q >> 1) * 128 + (q & 1) * 16); }
#pragma unroll
        for (int g = 0; g < 8; ++g) {
            const int ai = g >> 2, m = g & 3;
            f32x4 xv[4];
#pragma unroll
            for (int q = 0; q < 4; ++q) xv[q] = xn[q];
            if (g < 7) { const int g1 = g + 1; const float* xr = xbase + (size_t)(row0 + (g1 >> 2) * 128 + (g1 & 3) * 16) * 2048 + c0;
#pragma unroll
                for (int q = 0; q < 4; ++q) xn[q] = *(const f32x4*)(xr + (q >> 1) * 128 + (q & 1) * 16); }
            float* orow = out + (size_t)(row0 + ai * 128 + m * 16) * 2048 + c0;
#pragma unroll
            for (int q = 0; q < 4; ++q) *(f32x4*)(orow + (q >> 1) * 128 + (q & 1) * 16) = xv[q] * ALPHA + acc[ai][q >> 1][m][q & 1];
            asm volatile("" ::: "memory");
        }
    }
};

struct SchedOutLn {
    const char* A; const char* B; int c;
    __device__ __forceinline__ bool next(int i, Unit& u) const {
        if (i >= 5) return false;
        const int x = c & 7, j = c >> 3; const int pm = i * 32 + x * 4 + (j >> 3), pn = j & 7;
        u.A = A + (size_t)pm * 256 * 2048 * 2; u.B = B + (size_t)pn * 256 * 2048 * 2; u.nt = 32; u.pm = pm; u.pn = pn; u.aux = 0; return true;
    }
};
struct EpiOutLn {
    static constexpr bool PERM = false;
    const float* xp; const float* xs; float* out; bf16_t* xb; const float* lg; const float* lb;
    unsigned long long* X; unsigned* cnt; LAS unsigned char* el; signed char* xb8; float* xsc; const float* gbmax;
    __device__ __forceinline__ void operator()(f32x4 (&acc)[2][2][4][2], const Unit& u, int wr, int wc, int fr, int fq) const {
        const int tid = (wr * 4 + wc) * 64 + fq * 16 + fr;
        const int rl0 = wr * 64 + fr; const int c0 = u.pn * 256 + wc * 32 + 4 * fq;
        const float* xbase = (u.pm * 256 < TP) ? xp : (xs - (size_t)TP * 2048);
        const int e0 = (u.pm * 256 + rl0) * 2048 + c0;
        LAS f32x2* P = (LAS f32x2*)el;
        LAS f32x2* St = (LAS f32x2*)(el + 8192);
        LAS float* Pm = (LAS float*)(el + 10240);
        LAS float* Sq = (LAS float*)(el + 14336);
        LAS float* Gs = (LAS float*)(el + 15616);
        if (tid < 128) { const int cg = (tid & 63) * 4; const f32x4 t4 = *(const f32x4*)((tid < 64 ? lg : lb) + u.pn * 256 + cg); *(LAS f32x4*)(Gs + (tid < 64 ? 0 : 256) + cg) = t4; }
        f32x4 xv[4];
        { int e = e0; asm volatile("" : "+v"(e));
#pragma unroll
          for (int q = 0; q < 4; ++q) xv[q] = *(const f32x4*)(xbase + e + (q >> 1) * 128 + (q & 1) * 16); }
#pragma unroll
        for (int g = 0; g < 8; ++g) {
            const int ai = g >> 2, m = g & 3;
            float s = 0.f, ss = 0.f, zm = 0.f;
#pragma unroll
            for (int q = 0; q < 4; ++q) { const f32x4 z = xv[q] * ALPHA + acc[ai][q >> 1][m][q & 1]; acc[ai][q >> 1][m][q & 1] = z;
                s += (z[0] + z[1]) + (z[2] + z[3]); ss += (z[0] * z[0] + z[1] * z[1]) + (z[2] * z[2] + z[3] * z[3]);
                zm = fmaxf(zm, fmaxf(fmaxf(fabsf(z[0]), fabsf(z[1])), fmaxf(fabsf(z[2]), fabsf(z[3])))); }
            if (g < 7) { int e = e0; asm volatile("" : "+v"(e)); const int g1 = g + 1;
#pragma unroll
                for (int q = 0; q < 4; ++q) xv[q] = *(const f32x4*)(xbase + e + ((g1 >> 2) * 128 + (g1 & 3) * 16) * 2048 + (q >> 1) * 128 + (q & 1) * 16); }
            s += __shfl_xor(s, 16); s += __shfl_xor(s, 32); ss += __shfl_xor(ss, 16); ss += __shfl_xor(ss, 32);
            zm = fmaxf(zm, __shfl_xor(zm, 16)); zm = fmaxf(zm, __shfl_xor(zm, 32));
            { int pi = rl0 * 4 + wc; asm volatile("" : "+v"(pi));
              if (fq == 0) { P[pi + (ai * 128 + m * 16) * 4] = (f32x2){s, ss}; Pm[pi + (ai * 128 + m * 16) * 4] = zm; } }
            asm volatile("" ::: "memory");
        }
        __syncthreads();
        unsigned long long* xrow = X + ((size_t)u.pm * 256 + (tid & 255)) * 16;
        if (tid < 256) {
            const f32x2 a = P[tid * 4 + 0], b = P[tid * 4 + 1], c2 = P[tid * 4 + 2], d = P[tid * 4 + 3];
            const float S = (a[0] + b[0]) + (c2[0] + d[0]), Q = (a[1] + b[1]) + (c2[1] + d[1]);
            const float M = fmaxf(fmaxf(Pm[tid * 4 + 0], Pm[tid * 4 + 1]), fmaxf(Pm[tid * 4 + 2], Pm[tid * 4 + 3]));
            __hip_atomic_store(xrow + 2 * u.pn, ((unsigned long long)__float_as_uint(Q) << 32) | __float_as_uint(S), __ATOMIC_RELAXED, __HIP_MEMORY_SCOPE_AGENT);
            __hip_atomic_store(xrow + 2 * u.pn + 1, (unsigned long long)__float_as_uint(M), __ATOMIC_RELAXED, __HIP_MEMORY_SCOPE_AGENT);
        }
        __syncthreads();
        if (tid == 0) {
            __hip_atomic_fetch_add(cnt + u.pm, 1u, __ATOMIC_RELAXED, __HIP_MEMORY_SCOPE_AGENT);
            while (__hip_atomic_load(cnt + u.pm, __ATOMIC_RELAXED, __HIP_MEMORY_SCOPE_AGENT) < 8u) __builtin_amdgcn_s_sleep(1);
            __builtin_amdgcn_fence(__ATOMIC_ACQUIRE, "agent");
        }
        __syncthreads();
        if (tid < 256) {
            float S = 0.f, Q = 0.f, M = 0.f;
#pragma unroll
            for (int t = 0; t < 8; ++t) { const unsigned long long w = __hip_atomic_load(xrow + 2 * t, __ATOMIC_RELAXED, __HIP_MEMORY_SCOPE_AGENT); S += __uint_as_float((unsigned)w); Q += __uint_as_float((unsigned)(w >> 32));
                M = fmaxf(M, __uint_as_float((unsigned)__hip_atomic_load(xrow + 2 * t + 1, __ATOMIC_RELAXED, __HIP_MEMORY_SCOPE_AGENT))); }
            const float mean = S * (1.0f / 2048.0f); const float var = fmaxf(Q * (1.0f / 2048.0f) - mean * mean, 0.f); const float rstd = rsqrtf(var + LN_EPS);
            St[tid] = (f32x2){mean, rstd};
            const float bound = fmaxf((M + fabsf(mean)) * rstd * gbmax[0] + gbmax[1], 1e-20f);
            Sq[tid] = 127.0f / bound;
            if (xb8 && u.pn == 0) xsc[u.pm * 256 + tid] = bound * (1.0f / 127.0f);
        }
        __syncthreads();
#pragma unroll
        for (int g = 0; g < 8; ++g) {
            const int ai = g >> 2, m = g & 3; const int rl = ai * 128 + rl0 + m * 16;
            const f32x2 st = St[rl];
            int e = e0; asm volatile("" : "+v"(e));
            e += (ai * 128 + m * 16) * 2048;
            int cc = wc * 32 + 4 * fq; asm volatile("" : "+v"(cc));
#pragma unroll
            for (int q = 0; q < 4; ++q) {
                const f32x4 gq = *(const LAS f32x4*)(Gs + cc + (q >> 1) * 128 + (q & 1) * 16), bq = *(const LAS f32x4*)(Gs + 256 + cc + (q >> 1) * 128 + (q & 1) * 16);
                const f32x4 y = (acc[ai][q >> 1][m][q & 1] - st[0]) * st[1] * gq + bq;
                *(f32x4*)(out + e + (q >> 1) * 128 + (q & 1) * 16) = y;
                if (xb8) {
                    const float qs = Sq[rl];
                    const int q0 = (int)rintf(y[0] * qs), q1 = (int)rintf(y[1] * qs), q2 = (int)rintf(y[2] * qs), q3 = (int)rintf(y[3] * qs);
                    int e8 = (u.pm * 256 + rl0) * X8P + c0; asm volatile("" : "+v"(e8));
                    *(unsigned*)(xb8 + e8 + (ai * 128 + m * 16) * X8P + (q >> 1) * 128 + (q & 1) * 16) = (unsigned)(q0 & 255) | ((unsigned)(q1 & 255) << 8) | ((unsigned)(q2 & 255) << 16) | ((unsigned)(q3 & 255) << 24); }
            }
            asm volatile("" ::: "memory");
        }
    }
};

__device__ __forceinline__ void transpose_tile(LAS float* buf, const float* src, int ld_src, bf16_t* dst, int ld_dst, int r0, int c0) {
    const int tid = tid_opaque();
#pragma unroll
    for (int i = 0; i < 2; ++i) { const int e = tid + 512 * i; const int r = e >> 4, c4 = (e & 15) * 4;
        const f32x4 v = *(const f32x4*)(src + (size_t)(r0 + r) * ld_src + c0 + c4);
        buf[r * 65 + c4] = v[0]; buf[r * 65 + c4 + 1] = v[1]; buf[r * 65 + c4 + 2] = v[2]; buf[r * 65 + c4 + 3] = v[3]; }
    __syncthreads();
    { const int c = tid >> 3, r8 = (tid & 7) * 8; float v[8];
#pragma unroll
      for (int j = 0; j < 8; ++j) v[j] = buf[(r8 + j) * 65 + c];
      u32x4 w; w.x = cvt_pk_bf16(v[0], v[1]); w.y = cvt_pk_bf16(v[2], v[3]); w.z = cvt_pk_bf16(v[4], v[5]); w.w = cvt_pk_bf16(v[6], v[7]);
      *(u32x4*)(dst + (size_t)(c0 + c) * ld_dst + r0 + r8) = w; }
    __syncthreads();
}

__device__ __forceinline__ void transpose_block(LAS float* buf, const float* src, int ld_src, bf16_t* dst, int ld_dst, int r0, int c0) {
    const int tid = tid_opaque();
#pragma unroll
    for (int i = 0; i < 8; ++i) { const int e = tid + 512 * i; const int r = e >> 6, c4 = (e & 63) * 4;
        const f32x4 v = *(const f32x4*)(src + (size_t)(r0 + r) * ld_src + c0 + c4);
        buf[r * 257 + c4] = v[0]; buf[r * 257 + c4 + 1] = v[1]; buf[r * 257 + c4 + 2] = v[2]; buf[r * 257 + c4 + 3] = v[3]; }
    __syncthreads();
#pragma unroll
    for (int i = 0; i < 4; ++i) { const int e = tid + 512 * i; const int c = e >> 3, r8 = (e & 7) * 8; float v[8];
#pragma unroll
      for (int j = 0; j < 8; ++j) v[j] = buf[(r8 + j) * 257 + c];
      u32x4 w; w.x = cvt_pk_bf16(v[0], v[1]); w.y = cvt_pk_bf16(v[2], v[3]); w.z = cvt_pk_bf16(v[4], v[5]); w.w = cvt_pk_bf16(v[6], v[7]);
      *(u32x4*)(dst + (size_t)(c0 + c) * ld_dst + r0 + r8) = w; }
    __syncthreads();
}

__device__ __forceinline__ void cols_i8_item(LAS unsigned char* lds, const float* src, signed char* dst, float* scales, int it) {
    LAS float* cm = (LAS float*)lds;
    const int tid = tid_opaque();
    const int cidx = tid & 63, dp = tid >> 6;
    const float* wsrc = src + it * 64 + cidx + (size_t)(dp * 256) * NIN;
    float m = 0.f;
    for (int d = 0; d < 256; d += 8) {
        float t[8];
#pragma unroll
        for (int j = 0; j < 8; ++j) t[j] = wsrc[(size_t)(d + j) * NIN];
#pragma unroll
        for (int j = 0; j < 8; ++j) m = fmaxf(m, fabsf(t[j]));
    }
    cm[dp * 64 + cidx] = m;
    __syncthreads();
    float cmax = 0.f;
#pragma unroll
    for (int p = 0; p < 8; ++p) cmax = fmaxf(cmax, cm[p * 64 + cidx]);
    cmax = fmaxf(cmax, 1e-30f); const float qs = 127.0f / cmax;
    if (dp == 0) scales[it * 64 + cidx] = cmax * (1.0f / 127.0f);
    signed char* drow = dst + (size_t)(it * 64 + cidx) * 4096 + dp * 256;
    for (int d = 0; d < 256; d += 8) {
        float t[8];
#pragma unroll
        for (int j = 0; j < 8; ++j) t[j] = wsrc[(size_t)(d + j) * NIN];
        int q[8];
#pragma unroll
        for (int j = 0; j < 8; ++j) q[j] = (int)rintf(t[j] * qs) & 255;
        u32x2 w; w.x = (unsigned)q[0] | ((unsigned)q[1] << 8) | ((unsigned)q[2] << 16) | ((unsigned)q[3] << 24); w.y = (unsigned)q[4] | ((unsigned)q[5] << 8) | ((unsigned)q[6] << 16) | ((unsigned)q[7] << 24);
        *(u32x2*)(drow + d) = w;
    }
    __syncthreads();
}

__device__ __forceinline__ void fold_i8_item(LAS unsigned char* lds, const float* w_in_l, const float* w_amap_l, signed char* win8, float* wsi, int it) {
    LAS float* tt = (LAS float*)lds;
    LAS float* Mx = (LAS float*)(lds + 1024);
    LAS float* rmx = (LAS float*)(lds + 1024 + 8192);
    const int tid = tid_opaque();
    const int pg = it >> 3, dd0 = (it & 7) * 16; const int part = pg >> 2, g = pg & 3;
    if (tid < 128) tt[tid] = part == 0 ? cospif((float)tid * (1.0f / 64.0f)) : sinpif((float)tid * (1.0f / 64.0f));
    __syncthreads();
    {
        const int cc = tid & 127, q = tid >> 7;
        float a4[4] = {0.f, 0.f, 0.f, 0.f};
        const float* wm = w_amap_l + (size_t)g * 128 * 128 + dd0 + q * 4;
        for (int cp = 0; cp < 128; ++cp) {
            const float t = tt[(cc * cp) & 127];
            const f32x4 w = *(const f32x4*)(wm + (size_t)cp * 128);
            a4[0] += t * w[0]; a4[1] += t * w[1]; a4[2] += t * w[2]; a4[3] += t * w[3];
        }
        *(LAS f32x4*)(Mx + cc * 16 + q * 4) = (f32x4){a4[0], a4[1], a4[2], a4[3]};
    }
    __syncthreads();
    float o[4][16];
#pragma unroll
    for (int r = 0; r < 4; ++r)
#pragma unroll
        for (int j = 0; j < 16; ++j) o[r][j] = 0.f;
    const float* wa = w_in_l + (size_t)(tid * 4) * NIN + g * 128;
    for (int c4 = 0; c4 < 128; c4 += 4) {
        f32x4 wr_[4];
#pragma unroll
        for (int r = 0; r < 4; ++r) wr_[r] = *(const f32x4*)(wa + (size_t)r * NIN + c4);
#pragma unroll
        for (int e = 0; e < 4; ++e) {
            const f32x4 m0 = *(const LAS f32x4*)(Mx + (c4 + e) * 16), m1 = *(const LAS f32x4*)(Mx + (c4 + e) * 16 + 4), m2 = *(const LAS f32x4*)(Mx + (c4 + e) * 16 + 8), m3 = *(const LAS f32x4*)(Mx + (c4 + e) * 16 + 12);
#pragma unroll
            for (int r = 0; r < 4; ++r) { const float w = wr_[r][e];
#pragma unroll
                for (int j = 0; j < 4; ++j) { o[r][j] += w * m0[j]; o[r][4 + j] += w * m1[j]; o[r][8 + j] += w * m2[j]; o[r][12 + j] += w * m3[j]; } }
        }
    }
    float mx[16];
#pragma unroll
    for (int j = 0; j < 16; ++j) { mx[j] = fmaxf(fmaxf(fabsf(o[0][j]), fabsf(o[1][j])), fmaxf(fabsf(o[2][j]), fabsf(o[3][j])));
#pragma unroll
        for (int s = 32; s >= 1; s >>= 1) mx[j] = fmaxf(mx[j], __shfl_xor(mx[j], s)); }
    if ((tid & 63) == 0) {
#pragma unroll
        for (int j = 0; j < 16; ++j) rmx[(tid >> 6) * 16 + j] = mx[j]; }
    __syncthreads();
#pragma unroll
    for (int j = 0; j < 16; ++j) {
        float m = 0.f;
#pragma unroll
        for (int w = 0; w < 8; ++w) m = fmaxf(m, rmx[w * 16 + j]);
        m = fmaxf(m, 1e-30f); const float qs = 127.0f / m;
        const int row = part * 512 + g * 128 + dd0 + j;
        if (tid == 0) wsi[row] = m * (1.0f / 127.0f);
        const int q0 = (int)rintf(o[0][j] * qs) & 255, q1 = (int)rintf(o[1][j] * qs) & 255, q2 = (int)rintf(o[2][j] * qs) & 255, q3 = (int)rintf(o[3][j] * qs) & 255;
        *(unsigned*)(win8 + (size_t)row * 4096 + tid * 4) = (unsigned)q0 | ((unsigned)q1 << 8) | ((unsigned)q2 << 16) | ((unsigned)q3 << 24);
    }
    __syncthreads();
}
__device__ __forceinline__ void prep_win8(LAS unsigned char* lds, const float* w_in_l, const float* w_amap_l, signed char* win8, float* wsi) {
    for (int it = blockIdx.x; it < 176; it += gridDim.x) {
        if (it < 64) fold_i8_item(lds, w_in_l, w_amap_l, win8, wsi, it);
        else cols_i8_item(lds, w_in_l + 512, win8 + (size_t)1024 * 4096, wsi + 1024, it - 64);
    }
}
__device__ __forceinline__ void prep_phase(LAS unsigned char* lds, const Args& a) {
    unsigned char* ws = a.ws;
    const int tid = tid_opaque();
    const float* xp = a.in[0]; const float* xs = a.in[1];
    {
        signed char* xb8 = (signed char*)(ws + WS_XB8); float* xsc = (float*)(ws + WS_XSC);
        const int lane = tid & 63, wv = tid >> 6;
        for (int row = blockIdx.x * 8 + wv; row < T; row += gridDim.x * 8) {
            const float* src = (row < TP) ? (xp + (size_t)row * 2048) : (xs + (size_t)(row - TP) * 2048);
            f32x4 v[8]; float mxv = 0.f;
#pragma unroll
            for (int i = 0; i < 8; ++i) { v[i] = *(const f32x4*)(src + i * 256 + lane * 4); mxv = fmaxf(mxv, fmaxf(fmaxf(fabsf(v[i][0]), fabsf(v[i][1])), fmaxf(fabsf(v[i][2]), fabsf(v[i][3])))); }
#pragma unroll
            for (int o = 32; o >= 1; o >>= 1) mxv = fmaxf(mxv, __shfl_xor(mxv, o));
            mxv = fmaxf(mxv, 1e-20f); const float qs = 127.0f / mxv;
            if (lane == 0) xsc[row] = mxv * (1.0f / 127.0f);
#pragma unroll
            for (int i = 0; i < 8; ++i) {
                const int c = i * 256 + lane * 4;
                const int q0 = (int)rintf(v[i][0] * qs), q1 = (int)rintf(v[i][1] * qs), q2 = (int)rintf(v[i][2] * qs), q3 = (int)rintf(v[i][3] * qs);
                *(unsigned*)(xb8 + (size_t)row * X8P + c) = (unsigned)(q0 & 255) | ((unsigned)(q1 & 255) << 8) | ((unsigned)(q2 & 255) << 16) | ((unsigned)(q3 & 255) << 24);
            }
        }
    }
    {
        float* gb = (float*)(ws + WS_CTL) + 512;
        if (blockIdx.x < 2) {
            const int l = blockIdx.x; float g = 0.f, b = 0.f;
            for (int i = tid; i < 2048; i += NTHREADS) { g = fmaxf(g, fabsf(a.in[10][l * 2048 + i])); b = fmaxf(b, fabsf(a.in[11][l * 2048 + i])); }
#pragma unroll
            for (int o = 32; o >= 1; o >>= 1) { g = fmaxf(g, __shfl_xor(g, o)); b = fmaxf(b, __shfl_xor(b, o)); }
            if ((tid & 63) == 0) { atomicMax((unsigned*)(gb + 2 * l), __float_as_uint(g)); atomicMax((unsigned*)(gb + 2 * l + 1), __float_as_uint(b)); }
        }
        for (int it = blockIdx.x; it < 368; it += gridDim.x) {
            if (it < 64) fold_i8_item(lds, a.in[2], a.in[3], (signed char*)(ws + WS_WIN8), (float*)(ws + WS_WSI), it);
            else if (it < 176) cols_i8_item(lds, a.in[2] + 512, (signed char*)(ws + WS_WIN8) + (size_t)1024 * 4096, (float*)(ws + WS_WSI) + 1024, it - 64);
            else { const int l = (it - 176) / 96; cols_i8_item(lds, a.in[2] + (size_t)l * 2048 * NIN + 7680, (signed char*)(ws + WS_WG8) + (size_t)l * 6144 * 4096, (float*)(ws + WS_WSC) + (size_t)l * 6144, (it - 176) % 96); }
        }
    }
    {
        f32x2* rope = (f32x2*)(ws + WS_ROPE);
        for (int idx = blockIdx.x * NTHREADS + tid; idx < 8192 * 8; idx += gridDim.x * NTHREADS) {
            const int pos = idx >> 3, i = idx & 7;
            const float inv = powf(500000.0f, -(float)i * 0.125f);
            const float ang = (float)pos * inv;
            rope[idx] = (f32x2){cosf(ang), sinf(ang)};
        }
    }
    {
        LAS float* ct = (LAS float*)lds;
        for (int m = tid; m < 8192; m += NTHREADS) ct[m] = cospif((float)m * (1.0f / 4096.0f));
        __syncthreads();
        signed char* dp = (signed char*)(ws + WS_DP); signed char* ds = (signed char*)(ws + WS_DS);
        for (int k = blockIdx.x; k < 8192; k += gridDim.x) {
            for (int ch = tid; ch < 1024; ch += NTHREADS) {
                const int col = ch * 8; const int sn = col >= 4096; const int s0 = col & 4095;
                int q[8];
#pragma unroll
                for (int j = 0; j < 8; ++j) { const int mm = (k * (s0 + j)) & 8191; const float v = sn ? -ct[(mm - 2048) & 8191] : ct[mm]; q[j] = (int)rintf(v * 127.0f) & 255; }
                u32x2 w; w.x = (unsigned)q[0] | ((unsigned)q[1] << 8) | ((unsigned)q[2] << 16) | ((unsigned)q[3] << 24); w.y = (unsigned)q[4] | ((unsigned)q[5] << 8) | ((unsigned)q[6] << 16) | ((unsigned)q[7] << 24);
                *(u32x2*)(dp + (size_t)k * 8192 + col) = w;
            }
        }
        for (int k = blockIdx.x; k < 2048; k += gridDim.x) {
            if (tid < 256) { const int col = tid * 8; const int sn = col >= 1024; const int s0 = col & 1023;
                int q[8];
#pragma unroll
                for (int j = 0; j < 8; ++j) { const int mm = (4 * k * (s0 + j)) & 8191; const float v = sn ? -ct[(mm - 2048) & 8191] : ct[mm]; q[j] = (int)rintf(v * 127.0f) & 255; }
                u32x2 w; w.x = (unsigned)q[0] | ((unsigned)q[1] << 8) | ((unsigned)q[2] << 16) | ((unsigned)q[3] << 24); w.y = (unsigned)q[4] | ((unsigned)q[5] << 8) | ((unsigned)q[6] << 16) | ((unsigned)q[7] << 24);
                *(u32x2*)(ds + (size_t)k * 2048 + col) = w; }
        }
        __syncthreads();
    }
    {
        LAS float* buf = (LAS float*)lds;
        const float* wbr = a.in[8]; const float* wo = a.in[9];
        bf16_t* wb = (bf16_t*)(ws + WS_WB); bf16_t* wout = (bf16_t*)(ws + WS_WOUT);
        for (int it = blockIdx.x; it < 6 * 8 * 8; it += gridDim.x) {
            const int lk = it / 64, r = it % 64; const int tr = r & 7, tc = r >> 3;
            transpose_block(buf, wbr + (size_t)lk * 512 * 2048, 2048, wb + (size_t)lk * 2048 * 2048, 2048, tr * 64, tc * 256);
        }
        for (int it = blockIdx.x; it < 2 * 32 * 8; it += gridDim.x) {
            const int l = it / 256, r = it % 256; const int tr = r & 31, tc = r >> 5;
            transpose_block(buf, wo + (size_t)l * 2048 * 2048, 2048, wout + (size_t)l * 2048 * 2048, 2048, tr * 64, tc * 256);
        }
    }
}

__device__ __forceinline__ void pq_fold_row(bf16_t* R, int S, signed char* q8, float* qscale, int lane) {
    const int H = S >> 1; const int nch = H >> 3;
    float mx = 0.f;
    for (int cb = lane; cb < nch; cb += 256) {
        u32x4 pv[4], qv[4], pav[4], qav[4]; unsigned pbv[4], qbv[4];
#pragma unroll
        for (int j = 0; j < 4; ++j) { const int c = cb + 64 * j;
            if (c < nch) { pv[j] = *(const u32x4*)(R + 8 * c); qv[j] = *(const u32x4*)(R + H + 8 * c);
                pav[j] = *(const u32x4*)(R + S + (H - 8 * c - 8)); qav[j] = *(const u32x4*)(R + S + H + (H - 8 * c - 8));
                pbv[j] = 0u; qbv[j] = 0u;
                if (c > 0) { pbv[j] = *(const unsigned short*)(R + S + (H - 8 * c)); qbv[j] = *(const unsigned short*)(R + S + H + (H - 8 * c)); } } }
#pragma unroll
        for (int j = 0; j < 4; ++j) { const int c = cb + 64 * j;
            if (c < nch) {
                const u32x4 p = pv[j], q = qv[j], pa = pav[j], qa = qav[j]; const unsigned pb0 = pbv[j], qb0 = qbv[j];
                const float pf[8] = {bf_lo(p.x), bf_hi(p.x), bf_lo(p.y), bf_hi(p.y), bf_lo(p.z), bf_hi(p.z), bf_lo(p.w), bf_hi(p.w)};
                const float qf[8] = {bf_lo(q.x), bf_hi(q.x), bf_lo(q.y), bf_hi(q.y), bf_lo(q.z), bf_hi(q.z), bf_lo(q.w), bf_hi(q.w)};
                const float paf[8] = {bf_lo(pa.x), bf_hi(pa.x), bf_lo(pa.y), bf_hi(pa.y), bf_lo(pa.z), bf_hi(pa.z), bf_lo(pa.w), bf_hi(pa.w)};
                const float qaf[8] = {bf_lo(qa.x), bf_hi(qa.x), bf_lo(qa.y), bf_hi(qa.y), bf_lo(qa.z), bf_hi(qa.z), bf_lo(qa.w), bf_hi(qa.w)};
                float pe[8], qo[8];
                pe[0] = pf[0] + __uint_as_float(pb0 << 16); qo[0] = (c > 0) ? (qf[0] - __uint_as_float(qb0 << 16)) : 0.f;
#pragma unroll
                for (int e = 1; e < 8; ++e) { pe[e] = pf[e] + paf[8 - e]; qo[e] = qf[e] - qaf[8 - e]; }
#pragma unroll
                for (int e = 0; e < 8; ++e) mx = fmaxf(mx, fmaxf(fabsf(pe[e]), fabsf(qo[e])));
                u32x4 w; w.x = cvt_pk_bf16(pe[0], pe[1]); w.y = cvt_pk_bf16(pe[2], pe[3]); w.z = cvt_pk_bf16(pe[4], pe[5]); w.w = cvt_pk_bf16(pe[6], pe[7]);
                *(u32x4*)(R + 8 * c) = w;
                w.x = cvt_pk_bf16(qo[0], qo[1]); w.y = cvt_pk_bf16(qo[2], qo[3]); w.z = cvt_pk_bf16(qo[4], qo[5]); w.w = cvt_pk_bf16(qo[6], qo[7]);
                *(u32x4*)(R + H + 8 * c) = w;
            } }
    }
#pragma unroll
    for (int o = 32; o >= 1; o >>= 1) mx = fmaxf(mx, __shfl_xor(mx, o));
    mx = fmaxf(mx, 1e-30f); const float qs = 127.0f / mx;
    if (lane == 0) *qscale = mx * (1.0f / 127.0f);
    for (int c = lane; c < nch; c += 64) {
        const u32x4 p = *(const u32x4*)(R + 8 * c), q = *(const u32x4*)(R + H + 8 * c);
        const float pf[8] = {bf_lo(p.x), bf_hi(p.x), bf_lo(p.y), bf_hi(p.y), bf_lo(p.z), bf_hi(p.z), bf_lo(p.w), bf_hi(p.w)};
        const float qf[8] = {bf_lo(q.x), bf_hi(q.x), bf_lo(q.y), bf_hi(q.y), bf_lo(q.z), bf_hi(q.z), bf_lo(q.w), bf_hi(q.w)};
        int a8[8], b8[8];
#pragma unroll
        for (int e = 0; e < 8; ++e) { a8[e] = (int)rintf(pf[e] * qs) & 255; b8[e] = (int)rintf(qf[e] * qs) & 255; }
        u32x2 w; w.x = (unsigned)a8[0] | ((unsigned)a8[1] << 8) | ((unsigned)a8[2] << 16) | ((unsigned)a8[3] << 24); w.y = (unsigned)a8[4] | ((unsigned)a8[5] << 8) | ((unsigned)a8[6] << 16) | ((unsigned)a8[7] << 24);
        *(u32x2*)(q8 + 8 * c) = w;
        w.x = (unsigned)b8[0] | ((unsigned)b8[1] << 8) | ((unsigned)b8[2] << 16) | ((unsigned)b8[3] << 24); w.y = (unsigned)b8[4] | ((unsigned)b8[5] << 8) | ((unsigned)b8[6] << 16) | ((unsigned)b8[7] << 24);
        *(u32x2*)(q8 + H + 8 * c) = w;
    }
}

__device__ __forceinline__ void sgu_item(LAS unsigned char* lds, bf16_t* ys, const bf16_t* vb, const bf16_t* bz, const float* sw, const float* sb, const float* lg, const float* lb, int item, bool dry) {
    const int tid = tid_opaque(), lane = tid & 63, wid = tid >> 6;
    const int cidx = item >> 2, g = item & 3; const int t0 = cidx * 128;
    LAS bf16_t* vT = (LAS bf16_t*)lds;
    {
        const int q = tid >> 2, part = tid & 3;
        const bf16_t* vrow = vb + (size_t)(t0 + q) * 512;
        float s = 0.f, ss = 0.f;
#pragma unroll
        for (int i = 0; i < 16; ++i) {
            const u32x4 z = *(const u32x4*)(vrow + part * 128 + i * 8);
            const float f0 = bf_lo(z.x), f1 = bf_hi(z.x), f2 = bf_lo(z.y), f3 = bf_hi(z.y), f4 = bf_lo(z.z), f5 = bf_hi(z.z), f6 = bf_lo(z.w), f7 = bf_hi(z.w);
            s += ((f0 + f1) + (f2 + f3)) + ((f4 + f5) + (f6 + f7));
            ss += ((f0 * f0 + f1 * f1) + (f2 * f2 + f3 * f3)) + ((f4 * f4 + f5 * f5) + (f6 * f6 + f7 * f7));
        }
        s += __shfl_xor(s, 1); s += __shfl_xor(s, 2); ss += __shfl_xor(ss, 1); ss += __shfl_xor(ss, 2);
        const float mean = s * (1.0f / 512.0f); const float var = fmaxf(ss * (1.0f / 512.0f) - mean * mean, 0.f); const float rstd = rsqrtf(var + LN_EPS);
#pragma unroll
        for (int i = 0; i < 4; ++i) {
            const int c = part * 32 + i * 8;
            const u32x4 z = *(const u32x4*)(vrow + g * 128 + c);
            float f[8] = {bf_lo(z.x), bf_hi(z.x), bf_lo(z.y), bf_hi(z.y), bf_lo(z.z), bf_hi(z.z), bf_lo(z.w), bf_hi(z.w)};
#pragma unroll
            for (int e = 0; e < 8; e += 2) {
                const float y0 = (f[e] - mean) * rstd * lg[g * 128 + c + e] + lb[g * 128 + c + e];
                const float y1 = (f[e + 1] - mean) * rstd * lg[g * 128 + c + e + 1] + lb[g * 128 + c + e + 1];
                const unsigned w = cvt_pk_bf16(y0, y1);
                vT[(c + e) * 136 + q] = (bf16_t)(w & 0xffff); vT[(c + e + 1) * 136 + q] = (bf16_t)(w >> 16);
            }
        }
    }
    __syncthreads();
    {
        const int fr = lane & 15, quad = lane >> 4; const int p = wid * 16 + fr;
        bf16x8 bw[4];
        const float* wrow = sw + ((size_t)g * 128 + p) * 128;
#pragma unroll
        for (int ks = 0; ks < 4; ++ks) {
            const f32x4 a0 = *(const f32x4*)(wrow + ks * 32 + quad * 8), a1 = *(const f32x4*)(wrow + ks * 32 + quad * 8 + 4);
            u32x4 w; w.x = cvt_pk_bf16(a0[0], a0[1]); w.y = cvt_pk_bf16(a0[2], a0[3]); w.z = cvt_pk_bf16(a1[0], a1[1]); w.w = cvt_pk_bf16(a1[2], a1[3]);
            bw[ks] = __builtin_bit_cast(bf16x8, w);
        }
        const float bias = sb[g * 128 + p];
        const int t = t0 + p;
#pragma unroll
        for (int mt = 0; mt < 8; ++mt) {
            f32x4 acc = (f32x4){0.f, 0.f, 0.f, 0.f};
#pragma unroll
            for (int ks = 0; ks < 4; ++ks) {
                const bf16x8 av = *(const LAS bf16x8*)(vT + (16 * mt + fr) * 136 + ks * 32 + quad * 8);
                acc = __builtin_amdgcn_mfma_f32_16x16x32_bf16(av, bw[ks], acc, 0, 0, 0);
            }
            const int c4 = g * 128 + 16 * mt + 4 * quad;
            bf16_t* up = ys + (size_t)t * YLD + 512 + c4;
            const u32x2 uz = *(const u32x2*)up; const u32x2 zz = *(const u32x2*)(bz + (size_t)t * 512 + c4);
            u32x2 w;
            w.x = cvt_pk_bf16(bf_lo(uz.x) * (acc[0] + bias) * bf_lo(zz.x), bf_hi(uz.x) * (acc[1] + bias) * bf_hi(zz.x));
            w.y = cvt_pk_bf16(bf_lo(uz.y) * (acc[2] + bias) * bf_lo(zz.y), bf_hi(uz.y) * (acc[3] + bias) * bf_hi(zz.y));
            if (!dry) *(u32x2*)up = w;
        }
    }
    __syncthreads();
}

struct AttnGeo { int tbase, dil, L, r, m0, gh; };
__device__ __forceinline__ AttnGeo attn_decode(int item) {
    AttnGeo g; g.gh = item % 24; const int ua = item / 24; const int grp = g.gh >> 3;
    int S, u;
    if (ua < 256) { const int sq = ua >> 6; u = ua & 63; S = SP; g.tbase = sq * SP; }
    else { const int v = ua - 256; const int sq = v >> 4; u = v & 15; S = SS; g.tbase = TP + sq * SS; }
    const int dsh = 2 * grp; g.dil = 1 << dsh; g.L = S >> dsh;
    g.r = u & (g.dil - 1); g.m0 = (u >> dsh) * 128;
    return g;
}
__device__ __forceinline__ void attn_phase(LAS unsigned char* lds, bf16_t* qkv, float* lse, int first, int count, int stride, bool dry) {
    const int tid = tid_opaque(), lane = tid & 63, wid = tid >> 6, fr = lane & 15, quad = lane >> 4;
    constexpr int KST = 72;
    LAS bf16_t* Ks = (LAS bf16_t*)lds;
    LAS bf16_t* Vs = (LAS bf16_t*)(lds + 272 * KST * 2);
    u32x4 kz[4], vz[4]; bf16x8 bq[2];
#define ATT_LOAD(item_) do { const AttnGeo g_ = attn_decode(item_); \
        _Pragma("unroll") for (int i = 0; i < 4; ++i) { const int e = tid + 512 * i; const int key = e >> 3, dch = e & 7; const int mk = g_.m0 - 64 + key; const bool ok = (mk >= 0) && (mk < g_.L); \
            kz[i] = (u32x4){0u, 0u, 0u, 0u}; vz[i] = (u32x4){0u, 0u, 0u, 0u}; \
            if (ok) { const bf16_t* rowp = qkv + (size_t)(g_.tbase + mk * g_.dil + g_.r) * 4608 + g_.gh * 64 + dch * 8; kz[i] = *(const u32x4*)(rowp + 1536); vz[i] = *(const u32x4*)(rowp + 3072); } } \
        { const bf16_t* qrow_ = qkv + (size_t)(g_.tbase + (g_.m0 + 16 * wid + fr) * g_.dil + g_.r) * 4608 + g_.gh * 64; \
          bq[0] = *(const bf16x8*)(qrow_ + quad * 8); bq[1] = *(const bf16x8*)(qrow_ + 32 + quad * 8); } } while (0)
    if (count <= 0) return;
    __syncthreads();
    if (tid < 128) { const int key = 256 + (tid >> 3), dch = tid & 7;
        *(LAS u32x4*)(Ks + key * KST + dch * 8) = (u32x4){0u, 0u, 0u, 0u}; *(LAS u32x4*)(Vs + key * KST + dch * 8) = (u32x4){0u, 0u, 0u, 0u}; }
    ATT_LOAD(first);
    for (int n = 0; n < count; ++n) {
        const int item = first + n * stride;
        const AttnGeo g = attn_decode(item);
        __syncthreads();
#pragma unroll
        for (int i = 0; i < 4; ++i) { const int e = tid + 512 * i; const int key = e >> 3, dch = e & 7;
            *(LAS u32x4*)(Ks + key * KST + dch * 8) = kz[i]; *(LAS u32x4*)(Vs + key * KST + dch * 8) = vz[i]; }
        const bf16x8 q0 = bq[0], q1 = bq[1];
        __syncthreads();
        if (n + 1 < count) ATT_LOAD(item + stride);
        const int ql = 16 * wid + fr; const int mq = g.m0 + ql;
        float sc[10][4];
        float mx = -3.0e38f;
        const int klo = max(ql, 64 - g.m0), khi = min(ql + 128, g.L + 63 - g.m0);
        const int kbase = 16 * wid + 4 * quad - klo; const unsigned krng = (unsigned)(khi - klo);
#pragma unroll
        for (int ti = 0; ti < 10; ++ti) {
            const int kk0 = 16 * (wid + ti);
            f32x4 acc = (f32x4){0.f, 0.f, 0.f, 0.f};
            const bf16x8 ka0 = *(const LAS bf16x8*)(Ks + (kk0 + fr) * KST + quad * 8), ka1 = *(const LAS bf16x8*)(Ks + (kk0 + fr) * KST + 32 + quad * 8);
            acc = __builtin_amdgcn_mfma_f32_16x16x32_bf16(ka0, q0, acc, 0, 0, 0);
            acc = __builtin_amdgcn_mfma_f32_16x16x32_bf16(ka1, q1, acc, 0, 0, 0);
#pragma unroll
            for (int j = 0; j < 4; ++j) {
                const bool ok = (unsigned)(kbase + 16 * ti + j) <= krng;
                const float sv = ok ? acc[j] * 0.18033688011112042f : -1.0e30f;
                sc[ti][j] = sv; mx = fmaxf(mx, sv);
            }
        }
        mx = fmaxf(mx, __shfl_xor(mx, 16)); mx = fmaxf(mx, __shfl_xor(mx, 32));
        float sum = 0.f;
#pragma unroll
        for (int ti = 0; ti < 10; ++ti)
#pragma unroll
            for (int j = 0; j < 4; ++j) { const float p = __builtin_amdgcn_exp2f(sc[ti][j] - mx); sc[ti][j] = p; sum += p; }
        sum += __shfl_xor(sum, 16); sum += __shfl_xor(sum, 32);
        bf16x8 pb[5];
#pragma unroll
        for (int k2 = 0; k2 < 5; ++k2) {
            u32x4 w; w.x = cvt_pk_bf16(sc[2 * k2][0], sc[2 * k2][1]); w.y = cvt_pk_bf16(sc[2 * k2][2], sc[2 * k2][3]);
            w.z = cvt_pk_bf16(sc[2 * k2 + 1][0], sc[2 * k2 + 1][1]); w.w = cvt_pk_bf16(sc[2 * k2 + 1][2], sc[2 * k2 + 1][3]);
            pb[k2] = __builtin_bit_cast(bf16x8, w);
        }
        const float inv = 1.0f / sum;
        bf16_t* qrow = qkv + (size_t)(g.tbase + mq * g.dil + g.r) * 4608 + g.gh * 64;
        const unsigned vbase = (unsigned)(size_t)Vs + (unsigned)(((16 * wid + 4 * quad + (fr >> 2)) * KST + 4 * (fr & 3)) * 2);
#pragma unroll
        for (int mt = 0; mt < 4; ++mt) {
            u32x2 t0, t1, t2, t3, t4, t5, t6, t7, t8, t9;
            const unsigned va = vbase + mt * 32;
            asm volatile("ds_read_b64_tr_b16 %0, %10\n\tds_read_b64_tr_b16 %1, %10 offset:2304\n\tds_read_b64_tr_b16 %2, %10 offset:4608\n\tds_read_b64_tr_b16 %3, %10 offset:6912\n\t"
                         "ds_read_b64_tr_b16 %4, %10 offset:9216\n\tds_read_b64_tr_b16 %5, %10 offset:11520\n\tds_read_b64_tr_b16 %6, %10 offset:13824\n\tds_read_b64_tr_b16 %7, %10 offset:16128\n\t"
                         "ds_read_b64_tr_b16 %8, %10 offset:18432\n\tds_read_b64_tr_b16 %9, %10 offset:20736\n\ts_waitcnt lgkmcnt(0)"
                         : "=&v"(t0), "=&v"(t1), "=&v"(t2), "=&v"(t3), "=&v"(t4), "=&v"(t5), "=&v"(t6), "=&v"(t7), "=&v"(t8), "=&v"(t9) : "v"(va) : "memory");
            f32x4 o = (f32x4){0.f, 0.f, 0.f, 0.f};
            o = __builtin_amdgcn_mfma_f32_16x16x32_bf16(__builtin_bit_cast(bf16x8, ((u32x4){t0.x, t0.y, t1.x, t1.y})), pb[0], o, 0, 0, 0);
            o = __builtin_amdgcn_mfma_f32_16x16x32_bf16(__builtin_bit_cast(bf16x8, ((u32x4){t2.x, t2.y, t3.x, t3.y})), pb[1], o, 0, 0, 0);
            o = __builtin_amdgcn_mfma_f32_16x16x32_bf16(__builtin_bit_cast(bf16x8, ((u32x4){t4.x, t4.y, t5.x, t5.y})), pb[2], o, 0, 0, 0);
            o = __builtin_amdgcn_mfma_f32_16x16x32_bf16(__builtin_bit_cast(bf16x8, ((u32x4){t6.x, t6.y, t7.x, t7.y})), pb[3], o, 0, 0, 0);
            o = __builtin_amdgcn_mfma_f32_16x16x32_bf16(__builtin_bit_cast(bf16x8, ((u32x4){t8.x, t8.y, t9.x, t9.y})), pb[4], o, 0, 0, 0);
            u32x2 w; w.x = cvt_pk_bf16(o[0] * inv, o[1] * inv); w.y = cvt_pk_bf16(o[2] * inv, o[3] * inv);
            if (!dry) *(u32x2*)(qrow + 16 * mt + 4 * quad) = w;
        }
        if (quad == 0 && !dry) lse[(size_t)(g.tbase + mq * g.dil + g.r) * 24 + g.gh] = (mx + __log2f(sum)) * 0.6931471805599453f;
    }
#undef ATT_LOAD
    __syncthreads();
}

__device__ __forceinline__ void combine_phase(bf16_t* ys, const bf16_t* qkv, const float* lse, bool dry) {
    const size_t n = (size_t)T * 64;
    const int tid = tid_opaque();
    for (size_t id = (size_t)blockIdx.x * NTHREADS + tid; id < n; id += (size_t)gridDim.x * NTHREADS) {
        const int t = (int)(id >> 6), h = (int)(id >> 3) & 7, ch = (int)id & 7;
        const float l0 = lse[(size_t)t * 24 + h], l1 = lse[(size_t)t * 24 + 8 + h], l2 = lse[(size_t)t * 24 + 16 + h];
        const float mx = fmaxf(l0, fmaxf(l1, l2));
        float w0 = __expf(l0 - mx), w1 = __expf(l1 - mx), w2 = __expf(l2 - mx);
        const float inv = 1.0f / (w0 + w1 + w2); w0 *= inv; w1 *= inv; w2 *= inv;
        const bf16_t* qr = qkv + (size_t)t * 4608 + h * 64 + ch * 8;
        const u32x4 o0 = *(const u32x4*)qr, o1 = *(const u32x4*)(qr + 512), o2 = *(const u32x4*)(qr + 1024);
        bf16_t* yp = ys + (size_t)t * YLD + 1024 + h * 64 + ch * 8;
        const u32x4 z = *(const u32x4*)yp;
        u32x4 w;
        w.x = cvt_pk_bf16((w0 * bf_lo(o0.x) + w1 * bf_lo(o1.x) + w2 * bf_lo(o2.x)) * bf_lo(z.x), (w0 * bf_hi(o0.x) + w1 * bf_hi(o1.x) + w2 * bf_hi(o2.x)) * bf_hi(z.x));
        w.y = cvt_pk_bf16((w0 * bf_lo(o0.y) + w1 * bf_lo(o1.y) + w2 * bf_lo(o2.y)) * bf_lo(z.y), (w0 * bf_hi(o0.y) + w1 * bf_hi(o1.y) + w2 * bf_hi(o2.y)) * bf_hi(z.y));
        w.z = cvt_pk_bf16((w0 * bf_lo(o0.z) + w1 * bf_lo(o1.z) + w2 * bf_lo(o2.z)) * bf_lo(z.z), (w0 * bf_hi(o0.z) + w1 * bf_hi(o1.z) + w2 * bf_hi(o2.z)) * bf_hi(z.z));
        w.w = cvt_pk_bf16((w0 * bf_lo(o0.w) + w1 * bf_lo(o1.w) + w2 * bf_lo(o2.w)) * bf_lo(z.w), (w0 * bf_hi(o0.w) + w1 * bf_hi(o1.w) + w2 * bf_hi(o2.w)) * bf_hi(z.w));
        if (!dry) *(u32x4*)yp = w;
    }
}

__device__ __forceinline__ void ln_phase(float* out, bf16_t* xb, const float* lg, const float* lb, bool write_bf, bool dry) {
    const int tid = tid_opaque(); const int lane = tid & 63, wid = tid >> 6;
    for (int row = blockIdx.x * 8 + wid; row < T; row += gridDim.x * 8) {
        float* rp = out + (size_t)row * 2048;
        f32x4 v[8]; float s = 0.f;
#pragma unroll
        for (int i = 0; i < 8; ++i) { v[i] = *(const f32x4*)(rp + i * 256 + lane * 4); s += (v[i][0] + v[i][1]) + (v[i][2] + v[i][3]); }
#pragma unroll
        for (int o = 32; o >= 1; o >>= 1) s += __shfl_xor(s, o);
        const float mean = s * (1.0f / 2048.0f); float q = 0.f;
#pragma unroll
        for (int i = 0; i < 8; ++i) { const f32x4 d = v[i] - mean; q += (d[0] * d[0] + d[1] * d[1]) + (d[2] * d[2] + d[3] * d[3]); }
#pragma unroll
        for (int o = 32; o >= 1; o >>= 1) q += __shfl_xor(q, o);
        const float rstd = rsqrtf(q * (1.0f / 2048.0f) + LN_EPS);
#pragma unroll
        for (int i = 0; i < 8; ++i) {
            const int c = i * 256 + lane * 4;
            const f32x4 gg = *(const f32x4*)(lg + c), bb = *(const f32x4*)(lb + c);
            const f32x4 y = (v[i] - mean) * rstd * gg + bb;
            if (!dry) *(f32x4*)(rp + c) = y;
            if (write_bf && !dry) { u32x2 w; w.x = cvt_pk_bf16(y[0], y[1]); w.y = cvt_pk_bf16(y[2], y[3]); *(u32x2*)(xb + (size_t)row * 2048 + c) = w; }
        }
    }
}

__global__ void __launch_bounds__(NTHREADS) fwd_kernel(Args a) {
    extern __shared__ __attribute__((aligned(16))) unsigned char lds_raw[];
    LAS unsigned char* lds = (LAS unsigned char*)lds_raw;
    unsigned char* ws = a.ws;
    const int G = gridDim.x, c_blk = blockIdx.x;
    const int lo = a.ph_lo, hi = a.ph_hi;
#ifndef P2SUB
#define P2SUB 0xf
#endif
#ifndef PMASK
#define PMASK 0xff
#endif
#if SINGLE_LAUNCH
#define IN(k) (true)
#else
#define IN(k) (lo <= (k) && (k) < hi)
#endif
#define SEAM(k) do { if (IN(k) && IN((k) + 1)) { if (a.ph_lo == 0x7fffff01) cg::this_grid().sync();   ++nbar; grid_bar(ctl, nbar * (unsigned)G); } } while (0)
    unsigned nbar = 0;
    bf16_t* xb = (bf16_t*)(ws + WS_XB); bf16_t* win = (bf16_t*)(ws + WS_WIN);
    bf16_t* ys = (bf16_t*)(ws + WS_YS); bf16_t* vb = (bf16_t*)(ws + WS_VB); bf16_t* bzb = (bf16_t*)(ws + WS_BZ);
    bf16_t* qkv = (bf16_t*)(ws + WS_QKV); float* lse = (float*)(ws + WS_LSE);
    bf16_t* merged = (bf16_t*)(ws + WS_MERGED);
    unsigned* ctl = (unsigned*)(ws + WS_CTL);
    LAS int* qslot = (LAS int*)(lds + 128 * 1024);

    if (IN(0) && (PMASK & 1)) { prep_phase(lds, a); }
    SEAM(0);
#pragma nounroll
    for (int l = 0; l < 2; ++l) {
        const int pb = 1 + 6 * l;
        int c = c_blk; asm volatile("" : "+s"(c));
        if (IN(pb) && (PMASK & 2)) {
            { SchedIn8 S{(const char*)(ws + WS_XB8), (const char*)(ws + WS_WIN8), G, c};
              EpiIn<true> E{ys, vb, bzb, qkv, (bf16_t*)(ws + WS_PQTP), (bf16_t*)(ws + WS_PQTS), (const f32x2*)(ws + WS_ROPE), (const float*)(ws + WS_XSC), (const float*)(ws + WS_WSI)};
              pg8::gemm_phase<EpiIn<true>, SchedIn8, true>(lds, X8P / 2, 2048, S, E); }
        }
        SEAM(pb);
        if (IN(pb + 1)) {
            const int tidf = tid_opaque(); const int lane = tidf & 63;
            for (int row = c * 8 + (tidf >> 6); row < 2048; row += G * 8) {
                pq_fold_row((bf16_t*)(ws + WS_PQTP) + (size_t)row * 16384, SP, (signed char*)(ws + WS_PQ8P) + (size_t)row * 8192, (float*)(ws + WS_QSC) + row, lane);
                pq_fold_row((bf16_t*)(ws + WS_PQTS) + (size_t)row * 4096, SS, (signed char*)(ws + WS_PQ8S) + (size_t)row * 2048, (float*)(ws + WS_QSC) + 2048 + row, lane);
            }
        }
        SEAM(pb + 1);
        if (IN(pb + 2) && (PMASK & 4)) {
            {
            const bool dry = false;
            EpiDft E{ys, (const bf16_t*)(ws + WS_PQTP), (const bf16_t*)(ws + WS_PQTS), dry, (const float*)(ws + WS_QSC)};
            if (P2SUB & 1) { SchedDftP S{(const char*)(ws + WS_DP), (const char*)(ws + WS_PQ8P), G, c}; pg8::gemm_phase<EpiDft, SchedDftP, true>(lds, 4096, 4096, S, E); }
            if (P2SUB & 2) { SchedDftS S{(const char*)(ws + WS_DS), (const char*)(ws + WS_PQ8S), G, c}; pg8::gemm_phase<EpiDft, SchedDftS, true>(lds, 1024, 1024, S, E); }
            const float* sw = a.in[6] + (size_t)l * 4 * 128 * 128; const float* sb = a.in[7] + (size_t)l * 4 * 128;
            const float* slg = a.in[4] + (size_t)l * 512; const float* slb = a.in[5] + (size_t)l * 512;
            constexpr int N_SGU = (T / 128) * 4, N_ATT = (T / 128) * 24;
            if (P2SUB & 4) for (int item = c; item < N_SGU; item += G) sgu_item(lds, ys, vb, bzb, sw, sb, slg, slb, item, dry);
            if (P2SUB & 8) {
                if (G == 256) { const int first = c < 64 ? c * 27 : 1728 + (c - 64) * 31; attn_phase(lds, qkv, lse, first, c < 64 ? 27 : 31, 1, dry); }
                else attn_phase(lds, qkv, lse, c, (N_ATT - c + G - 1) / G, G, dry);
            }
            }
        }
        SEAM(pb + 2);
        if (IN(pb + 3) && (PMASK & 8)) {
            combine_phase(ys, qkv, lse, false);
        }
        SEAM(pb + 3);
        if (IN(pb + 4) && (PMASK & 16)) {
            unsigned char* scr = ws + WS_SCR + (size_t)c * SCR_PER_WG;
            EpiGate EG{(u32x4*)scr, (const float*)(ws + WS_XSC), (const float*)(ws + WS_WSC) + (size_t)l * 6144};
            EpiProj EP{(const u32x4*)scr, merged};
#pragma nounroll
            for (int ti = 0; ti < (T / 256) * 8; ti += G) {
                int pm = 0, pn = 0; const bool ok = pg8::grid_tile(ti + c, T / 256, 8, pm, pn);
                SchedGate SG{(const char*)(ws + WS_XB8), (const char*)(ws + WS_WG8 + (size_t)l * 6144 * 4096), pm, pn, ok};
                pg8::gemm_phase<EpiGate, SchedGate, true>(lds, X8P / 2, 2048, SG, EG);
                SchedProj SPj{(const char*)ys, (const char*)(ws + WS_WB + (size_t)l * 3 * 2048 * 2048 * 2), pm, pn, ok};
                pg8::gemm_phase<EpiProj, SchedProj>(lds, YLD, 2048, SPj, EP);
            }
        }
        SEAM(pb + 4);
        if (IN(pb + 5) && (PMASK & 32)) {
            {
                SchedOutLn S{(const char*)merged, (const char*)(ws + WS_WOUT + (size_t)l * 2048 * 2048 * 2), c};
                EpiOutLn E{l == 0 ? a.in[0] : a.out, l == 0 ? a.in[1] : (a.out + (size_t)TP * 2048), a.out, (bf16_t*)nullptr,
                           a.in[10] + (size_t)l * 2048, a.in[11] + (size_t)l * 2048,
                           (unsigned long long*)(ws + WS_XCH) + (size_t)l * 160 * 256 * 16, ctl + 64 + l * 160, lds + 128 * 1024 + 256,
                           l == 0 ? (signed char*)(ws + WS_XB8) : (signed char*)nullptr, (float*)(ws + WS_XSC), (const float*)(ws + WS_CTL) + 512 + 2 * l};
                pg8::gemm_phase<EpiOutLn, SchedOutLn>(lds, 2048, 2048, S, E);
            }
            if (l == 0) {
                prep_win8(lds, a.in[2] + (size_t)2048 * NIN, a.in[3] + (size_t)4 * 128 * 128, (signed char*)(ws + WS_WIN8), (float*)(ws + WS_WSI));
            }
        }
        if (l == 0) SEAM(pb + 5);
    }
#undef IN
#undef SEAM
}

constexpr int N_PHASES = 13;
__global__ void fill_kernel(float* p, size_t n, float v) { for (size_t i = (size_t)blockIdx.x * blockDim.x + threadIdx.x; i < n; i += (size_t)gridDim.x * blockDim.x) p[i] = v; }

extern "C" void kernel_launch(void* const* d_in, const int* in_sizes, int n_in, void* d_out, int out_size, void* d_ws, size_t ws_size, hipStream_t stream) {
    static int grid = 0;
    if (grid == 0) {
        int dev = 0, cus = 0, per_cu = 0;
        hipGetDevice(&dev);
        hipDeviceGetAttribute(&cus, hipDeviceAttributeMultiprocessorCount, dev);
        if (hipFuncSetAttribute((const void*)fwd_kernel, hipFuncAttributeMaxDynamicSharedMemorySize, LDS_BYTES) != hipSuccess) fprintf(stderr, "kernel_launch: hipFuncSetAttribute failed\n");
        hipOccupancyMaxActiveBlocksPerMultiprocessor(&per_cu, (const void*)fwd_kernel, NTHREADS, LDS_BYTES);
        if (per_cu < 1) { fprintf(stderr, "kernel_launch: occupancy query says %d blocks per CU\n", per_cu); per_cu = 1; }
        (void)hipGetLastError();
        grid = 256;
        if (cus != 256) fprintf(stderr, "kernel_launch: built for 256 CUs, device reports %d\n", cus);
        if (ws_size < WS_END) fprintf(stderr, "kernel_launch: workspace too small: %zu < %zu\n", ws_size, (size_t)WS_END);
    }
    if (ws_size < WS_END) { hipLaunchKernelGGL(fill_kernel, dim3(1024), dim3(256), 0, stream, (float*)d_out, (size_t)out_size, (float)((double)ws_size / 268435456.0)); return; }
    hipMemsetAsync((char*)d_ws + WS_CTL, 0, 4096, stream);
    Args a{};
    for (int i = 0; i < 12; ++i) a.in[i] = (const float*)d_in[i];
    a.out = (float*)d_out; a.ws = (unsigned char*)d_ws;
    { const int reps[6] = {PROBE_REPS}; for (int i = 0; i < 6; ++i) a.rep[i] = reps[i]; }
#if SINGLE_LAUNCH
    a.ph_lo = 0; a.ph_hi = N_PHASES;
    void* args[] = {&a};
    hipError_t e = hipLaunchCooperativeKernel((const void*)fwd_kernel, dim3(grid), dim3(NTHREADS), args, LDS_BYTES, stream);
    if (e != hipSuccess) fprintf(stderr, "cooperative launch failed: %s (grid %d)\n", hipGetErrorString(e), grid);
#else
    for (int p = 0; p < N_PHASES; ++p) {
        a.ph_lo = p; a.ph_hi = p + 1;
        hipLaunchKernelGGL(fwd_kernel, dim3(grid), dim3(NTHREADS), LDS_BYTES, stream, a);
    }
#endif
}
```
